# Optimizing an MI355X kernel written in HIP

```python
import jax, jax.numpy as jnp
from jax import lax
import numpy as np

D_MODEL = 1024
BATCH = 8
SEQ = 2048
DEPTH = 4
DEC_BATCH = 128
DEC_SEQ = 1
PAST_LEN = 16384
PAGE_SIZE = 128

H_A = 4
DK = D_MODEL // 8
DV = D_MODEL // 8
QK_DIM = H_A * DK
V_DIM = H_A * DV
QKV_DIM = 2 * QK_DIM + V_DIM
CONV_A = 4
DELTA_CHUNK = 64
H_B = 4
D_B = D_MODEL // 8
SGU_DIM = H_B * D_B
SGU_CHUNK = 128
OFF_Z = QKV_DIM
OFF_BETA = OFF_Z + V_DIM
OFF_ALPHA = OFF_BETA + H_A
OFF_U = OFF_ALPHA + H_A
OFF_VB = OFF_U + SGU_DIM
IN_DIM = OFF_VB + SGU_DIM
MIX_DIM = V_DIM + SGU_DIM
D_FF = ((8 * D_MODEL // 3 + 127) // 128) * 128
CONV_F = 3
N_MOD = 6
EPS = 1e-6

kernel_name = "hymba_gdn_chunkmlp_convffn_adaln_step"


def rms_norm(x, w):
    xf = x.astype(jnp.float32)
    y = xf * lax.rsqrt(jnp.mean(xf * xf, axis=-1, keepdims=True) + EPS)
    return y * w.astype(jnp.float32)


def l2_normalize(x):
    xf = x.astype(jnp.float32)
    return xf * lax.rsqrt(jnp.sum(xf * xf, axis=-1, keepdims=True) + EPS)


def causal_dwconv(x, prev, w):
    width = w.shape[0]
    T = x.shape[1]
    xp = jnp.concatenate([prev.astype(x.dtype), x], axis=1)
    y = xp[:, 0:T] * w[0]
    for j in range(1, width):
        y = y + xp[:, j:j + T] * w[j]
    return y, xp[:, T:]


def gated_delta_rule(q, k, v, g, beta, s0):
    nb, T = q.shape[0], q.shape[1]
    C = DELTA_CHUNK
    pad = (-T) % C
    n = (T + pad) // C
    q = l2_normalize(q) * (DK ** -0.5)
    k = l2_normalize(k)
    v = v.astype(jnp.float32)
    g = g.astype(jnp.float32)
    beta = beta.astype(jnp.float32)

    def to_chunks(a):
        a = jnp.pad(a, [(0, 0), (0, pad)] + [(0, 0)] * (a.ndim - 2))
        a = a.reshape((nb, n, C) + a.shape[2:])
        a = jnp.moveaxis(a, 3, 2)
        return jnp.moveaxis(a, 1, 0)

    qc, kc, vc, gc, bc = (to_chunks(a) for a in (q, k, v, g, beta))
    gcum = jnp.cumsum(gc, axis=-1)
    tril = jnp.tril(jnp.ones((C, C), dtype=bool))
    strict = jnp.tril(jnp.ones((C, C), dtype=bool), -1)
    decay = jnp.exp(jnp.where(tril, gcum[..., :, None] - gcum[..., None, :], -jnp.inf))
    kb = kc * bc[..., None]
    vb = vc * bc[..., None]
    lower = jnp.where(strict, jnp.einsum('nbhid,nbhjd->nbhij', kb, kc) * decay, 0.0)
    a_mat = lower + jnp.eye(C, dtype=jnp.float32)
    rhs = jnp.concatenate([vb, kb * jnp.exp(gcum)[..., None]], axis=-1)
    sol = lax.linalg.triangular_solve(a_mat, rhs, left_side=True, lower=True, unit_diagonal=True)
    u_c = sol[..., :DV]
    w_c = sol[..., DV:]
    qk = jnp.where(tril, jnp.einsum('nbhid,nbhjd->nbhij', qc, kc) * decay, 0.0)

    def step(S, xs):
        q_i, k_i, u_i, w_i, qk_i, g_i = xs
        v_new = u_i - jnp.einsum('bhck,bhkv->bhcv', w_i, S)
        o = (jnp.einsum('bhck,bhkv->bhcv', q_i * jnp.exp(g_i)[..., None], S)
             + jnp.einsum('bhij,bhjv->bhiv', qk_i, v_new))
        g_last = g_i[..., -1]
        k_dec = k_i * jnp.exp(g_last[..., None] - g_i)[..., None]
        S = S * jnp.exp(g_last)[..., None, None] + jnp.einsum('bhck,bhcv->bhkv', k_dec, v_new)
        return S, o

    S, o = lax.scan(step, s0.astype(jnp.float32), (qc, kc, u_c, w_c, qk, gcum))
    o = jnp.transpose(o, (1, 0, 3, 2, 4)).reshape(nb, n * C, H_A, DV)[:, :T]
    return o, S


def chunk_spatial_gating(u, v, w_s, b_s):
    nb, T = v.shape[0], v.shape[1]
    C = SGU_CHUNK
    pad = (-T) % C
    n = (T + pad) // C
    vp = jnp.pad(v, ((0, 0), (0, pad), (0, 0), (0, 0))).reshape(nb, n, C, H_B, D_B)
    w = jnp.where(jnp.tril(jnp.ones((C, C), dtype=bool)), w_s, 0.0)
    z = jnp.einsum('hij,bnjhd->bnihd', w, vp) + b_s.T[None, None, :, :, None]
    z = z.reshape(nb, n * C, H_B, D_B)[:, :T]
    return u * z


def run_trunk(x, c, s_delta, s_qkv, s_ffn, w_mod, b_mod, norm1, w_in, conv_qkv, a_log,
              dt_bias, gdn_norm, sgu_norm, w_sgu, b_sgu, w_out, norm2, w_up, conv_ffn_w,
              conv_ffn_b, w_down, final_norm):
    nb, T = x.shape[0], x.shape[1]
    new_S, new_qkv, new_ffn, v_rows = [], [], [], []
    c_act = jax.nn.silu(c)
    for l in range(DEPTH):
        mod = (c_act @ w_mod[l] + b_mod[l])[:, None, :]
        sh1, sc1, g1, sh2, sc2, g2 = jnp.split(mod, N_MOD, axis=-1)
        h = (rms_norm(x, norm1[l]) * (1.0 + sc1) + sh1).astype(x.dtype)
        proj = h @ w_in[l]
        qkv = proj[..., :OFF_Z]
        z = proj[..., OFF_Z:OFF_BETA].reshape(nb, T, H_A, DV)
        b_raw = proj[..., OFF_BETA:OFF_ALPHA]
        a_raw = proj[..., OFF_ALPHA:OFF_U]
        u_raw = proj[..., OFF_U:OFF_VB]
        vb_raw = proj[..., OFF_VB:]
        qkv_c, qkv_buf = causal_dwconv(qkv, s_qkv[l], conv_qkv[l])
        qkv_c = jax.nn.silu(qkv_c)
        q = qkv_c[..., :QK_DIM].reshape(nb, T, H_A, DK)
        k = qkv_c[..., QK_DIM:2 * QK_DIM].reshape(nb, T, H_A, DK)
        v = qkv_c[..., 2 * QK_DIM:].reshape(nb, T, H_A, DV)
        beta = jax.nn.sigmoid(b_raw.astype(jnp.float32))
        g = -jnp.exp(a_log[l].astype(jnp.float32)) * jax.nn.softplus(
            a_raw.astype(jnp.float32) + dt_bias[l].astype(jnp.float32))
        o_a, S = gated_delta_rule(q, k, v, g, beta, s_delta[l])
        o_a = rms_norm(o_a, gdn_norm[l]) * jax.nn.silu(z.astype(jnp.float32))
        u = jax.nn.gelu(u_raw.astype(jnp.float32)).reshape(nb, T, H_B, D_B)
        vv = rms_norm(jax.nn.gelu(vb_raw.astype(jnp.float32)).reshape(nb, T, H_B, D_B), sgu_norm[l])
        o_b = chunk_spatial_gating(u, vv, w_sgu[l].astype(jnp.float32), b_sgu[l].astype(jnp.float32))
        mix = jnp.concatenate([o_a.reshape(nb, T, V_DIM), o_b.reshape(nb, T, SGU_DIM)],
                              axis=-1).astype(x.dtype)
        x = x + g1 * (mix @ w_out[l])
        h2 = (rms_norm(x, norm2[l]) * (1.0 + sc2) + sh2).astype(x.dtype)
        up = h2 @ w_up[l]
        up_c, ffn_buf = causal_dwconv(up, s_ffn[l], conv_ffn_w[l])
        up_c = up_c + conv_ffn_b[l]
        x = x + g2 * ((jax.nn.silu(up_c[..., :D_FF]) * up_c[..., D_FF:]) @ w_down[l])
        new_S.append(S.astype(s_delta.dtype))
        new_qkv.append(qkv_buf)
        new_ffn.append(ffn_buf)
        v_rows.append(vv.astype(x.dtype))
    y = rms_norm(x, final_norm).astype(x.dtype)
    return y, jnp.stack(new_S), jnp.stack(new_qkv), jnp.stack(new_ffn), v_rows


def setup_inputs(seed: int = 0) -> dict:
    key = jax.random.key(seed)
    ks = jax.random.split(key, 32)
    nrm = lambda k, s, sc: jax.random.normal(k, s, jnp.float32) * sc
    dt = jnp.exp(jax.random.uniform(ks[12], (DEPTH, H_A), jnp.float32,
                                    np.log(1e-3).astype(np.float32), np.log(1e-1).astype(np.float32)))
    return {
        "x_prompt": nrm(ks[0], (BATCH, SEQ, D_MODEL), 1.0),
        "x_sample": nrm(ks[1], (DEC_BATCH, DEC_SEQ, D_MODEL), 1.0),
        "state_delta": nrm(ks[2], (DEPTH, DEC_BATCH, H_A, DK, DV), 0.5),
        "state_qkv_conv": nrm(ks[3], (DEPTH, DEC_BATCH, CONV_A - 1, QKV_DIM), 1.0),
        "state_ffn_conv": nrm(ks[4], (DEPTH, DEC_BATCH, CONV_F - 1, 2 * D_FF), 1.0),
        "c_prompt": nrm(ks[5], (BATCH, D_MODEL), 1.0),
        "c_sample": nrm(ks[6], (DEC_BATCH, D_MODEL), 1.0),
        "w_mod": nrm(ks[7], (DEPTH, D_MODEL, N_MOD * D_MODEL), 0.02),
        "b_mod": nrm(ks[8], (DEPTH, N_MOD * D_MODEL), 0.02),
        "norm1": 1.0 + nrm(ks[9], (DEPTH, D_MODEL), 0.02),
        "w_in": nrm(ks[10], (DEPTH, D_MODEL, IN_DIM), D_MODEL ** -0.5),
        "conv_qkv": nrm(ks[11], (DEPTH, CONV_A, QKV_DIM), CONV_A ** -0.5),
        "a_log": jnp.log(jax.random.uniform(ks[13], (DEPTH, H_A), jnp.float32, 1.0, 16.0)),
        "dt_bias": dt + jnp.log(-jnp.expm1(-dt)),
        "gdn_norm": 1.0 + nrm(ks[14], (DEPTH, DV), 0.02),
        "sgu_norm": 1.0 + nrm(ks[15], (DEPTH, H_B, D_B), 0.02),
        "w_sgu": nrm(ks[16], (DEPTH, H_B, SGU_CHUNK, SGU_CHUNK), SGU_CHUNK ** -0.5),
        "b_sgu": 1.0 + nrm(ks[17], (DEPTH, H_B, SGU_CHUNK), 0.02),
        "w_out": nrm(ks[18], (DEPTH, MIX_DIM, D_MODEL), MIX_DIM ** -0.5),
        "norm2": 1.0 + nrm(ks[19], (DEPTH, D_MODEL), 0.02),
        "w_up": nrm(ks[20], (DEPTH, D_MODEL, 2 * D_FF), D_MODEL ** -0.5),
        "conv_ffn_w": nrm(ks[21], (DEPTH, CONV_F, 2 * D_FF), CONV_F ** -0.5),
        "conv_ffn_b": nrm(ks[22], (DEPTH, 2 * D_FF), 0.02),
        "w_down": nrm(ks[23], (DEPTH, D_FF, D_MODEL), D_FF ** -0.5),
        "final_norm": 1.0 + nrm(ks[24], (D_MODEL,), 0.02),
    }


def reference(x_prompt, x_sample, state_delta, state_qkv_conv, state_ffn_conv, c_prompt, c_sample,
              w_mod, b_mod, norm1, w_in, conv_qkv, a_log, dt_bias, gdn_norm, sgu_norm, w_sgu, b_sgu,
              w_out, norm2, w_up, conv_ffn_w, conv_ffn_b, w_down, final_norm):
    weights = (w_mod, b_mod, norm1, w_in, conv_qkv, a_log, dt_bias, gdn_norm, sgu_norm, w_sgu,
               b_sgu, w_out, norm2, w_up, conv_ffn_w, conv_ffn_b, w_down, final_norm)
    nbp = x_prompt.shape[0]
    s0_delta = jnp.zeros((DEPTH, nbp, H_A, DK, DV), state_delta.dtype)
    s0_qkv = jnp.zeros((DEPTH, nbp, CONV_A - 1, QKV_DIM), x_prompt.dtype)
    s0_ffn = jnp.zeros((DEPTH, nbp, CONV_F - 1, 2 * D_FF), x_prompt.dtype)
    y_prompt, delta_p, qkv_p, ffn_p, _ = run_trunk(x_prompt, c_prompt, s0_delta, s0_qkv, s0_ffn, *weights)
    y_sample, delta_s, qkv_s, ffn_s, v_rows_s = run_trunk(
        x_sample, c_sample, state_delta, state_qkv_conv, state_ffn_conv, *weights)
    sgu_v_s = jnp.stack(v_rows_s)
    return (y_prompt, y_sample, delta_p, delta_s, qkv_p, qkv_s, ffn_p, ffn_s, sgu_v_s)
```

```cpp
#include <hip/hip_runtime.h>
#include <hip/hip_cooperative_groups.h>
#include <cstdio>
namespace cg = cooperative_groups;
namespace pg8 {
#define PG8_LAS __attribute__((address_space(3)))
typedef unsigned short bf16_t;
typedef short bf16x8 __attribute__((ext_vector_type(8)));
typedef float f32x4 __attribute__((ext_vector_type(4)));
typedef unsigned u32x4 __attribute__((ext_vector_type(4)));
constexpr int BM = 256, BK = 64, HALF = 128, HTB = HALF * BK * 2  , STAGE_BYTES = 8 * HTB, NXCD = 8, WGM = 8;

__host__ __device__ __forceinline__ int lds_byte(int r, int c) { const int st = (r >> 4) * 2 + (c >> 5), rr = r & 15, cc = c & 31, ob = rr * 64 + cc * 2; return st * 1024 + (ob ^ (((ob >> 9) & 1) << 5)); }
__host__ __device__ __forceinline__ void stage_rc(int b, int& R, int& C) { const int st = b / 1024, sb = b % 1024, swz = sb ^ (((sb >> 9) & 1) << 5); R = (st >> 1) * 16 + swz / 64; C = (st & 1) * 32 + (swz % 64) / 2; }
__host__ __device__ __forceinline__ int perm32(int rho) { const int n = rho >> 4, i = rho & 15; return 8 * (i >> 2) + 4 * n + (i & 3); }

struct Unit { int pm, pn; };
struct Gemm { const bf16_t* A; const bf16_t* Bt; int M, N, K; };

struct StaticOrder {
    int nM, nN, nwg, G, c;
    __host__ __device__ void init(int M, int N, int G_, int c_) { nM = M / BM; nN = N / BM; nwg = nM * nN; G = G_; c = c_; }
    __host__ __device__ bool next(int i, Unit& u) const {
        const long L = (long)i * G + c; if (L >= nwg) return false;
        int wgid = (int)L; { const int q = nwg / NXCD, r = nwg % NXCD, xcd = wgid % NXCD, off = wgid / NXCD; wgid = (xcd < r ? xcd * (q + 1) : r * (q + 1) + (xcd - r) * q) + off; }
        const int nig = WGM * nN, gid = wgid / nig, fm = gid * WGM, gsz = (nM - fm) < WGM ? (nM - fm) : WGM;
        u.pm = fm + ((wgid % nig) % gsz); u.pn = (wgid % nig) / gsz; return true;
    }
    __device__ __forceinline__ void a_ready(const Unit&) const {}
    __device__ __forceinline__ void done(const Unit&) const {}
};
__device__ __forceinline__ unsigned cvt_pk_bf16(float lo, float hi) { unsigned r; asm volatile("v_cvt_pk_bf16_f32 %0, %1, %2" : "=v"(r) : "v"(lo), "v"(hi)); return r; }
template <class Epi, class Sched, bool STAMP = false>
__device__ __forceinline__ void gemm_phase(PG8_LAS unsigned char* lds, const Gemm g, const Sched& S, const Epi& E, unsigned long long* stamps) {
    int tid_ = threadIdx.x; asm volatile("" : "+v"(tid_)); const int tid = tid_, wid = __builtin_amdgcn_readfirstlane(tid >> 6), lane = tid & 63, wr = wid >> 2, wc = wid & 3, fr = lane & 15, fq = lane >> 4;
    const int K = g.K, nt = K / BK;
    int ts_lo = 0, ts_hi = 0, nts = 0; const unsigned long long rt_entry = STAMP ? (unsigned long long)wall_clock64() : 0ull;
#define PG8_STAMP() do { if (STAMP && wid == 0 && nts < 64) { const unsigned long long _c = (unsigned long long)clock64(); \
        ts_lo = (lane == nts) ? (int)(unsigned)_c : ts_lo; ts_hi = (lane == nts) ? (int)(unsigned)(_c >> 32) : ts_hi; ++nts; } } while (0)
    PG8_STAMP();
    unsigned voffA[2], voffB[2];
#pragma unroll
    for (int i = 0; i < 2; ++i) { int R, C; stage_rc(tid * 16 + i * 8192, R, C); const int Rb = Epi::PERM ? ((R & ~31) + perm32(R & 31)) : R;
        voffA[i] = (unsigned)(R * K + C) * 2u; voffB[i] = (unsigned)(Rb * K + C) * 2u; }
    const size_t kstep = (size_t)(BK * 2);
    const size_t hstep = (size_t)HALF * K * 2;
    const size_t tstep = 2 * hstep;
    const unsigned ldsw = (unsigned)wid * 1024u;
    const int aoff = lds_byte(wr * 64 + fr, fq * 8), boff = lds_byte(wc * 32 + fr, fq * 8);
#define PG8_SA(b, h) (((b) * 2 + (h)) * HTB)
#define PG8_SB(b, h) ((4 + (b) * 2 + (h)) * HTB)
#define PG8_STAGE(bufoff, gbase, voff) do { _Pragma("unroll") for (int _i = 0; _i < 2; ++_i) \
        __builtin_amdgcn_global_load_lds((const unsigned*)((const char*)(gbase) + (voff)[_i]), (PG8_LAS unsigned*)(lds + (bufoff) + ldsw + _i * 8192), 16, 0, 0); } while (0)
#define PG8_LDA(dst, b, h) do { _Pragma("unroll") for (int m = 0; m < 4; ++m) _Pragma("unroll") for (int k = 0; k < 2; ++k) dst[m][k] = *(const PG8_LAS bf16x8*)(lds + PG8_SA(b, h) + aoff + m * 2048 + k * 1024); } while (0)
#define PG8_LDB(dst, b, h) do { _Pragma("unroll") for (int n = 0; n < 2; ++n) _Pragma("unroll") for (int k = 0; k < 2; ++k) dst[n][k] = *(const PG8_LAS bf16x8*)(lds + PG8_SB(b, h) + boff + n * 2048 + k * 1024); } while (0)
#define PG8_MMA(ai, bj, At, Bt) do { __builtin_amdgcn_s_setprio(1); _Pragma("unroll") for (int m = 0; m < 4; ++m) _Pragma("unroll") for (int n = 0; n < 2; ++n) _Pragma("unroll") for (int k = 0; k < 2; ++k) \
        acc[ai][bj][m][n] = __builtin_amdgcn_mfma_f32_16x16x32_bf16(Bt[n][k], At[m][k], acc[ai][bj][m][n], 0, 0, 0); __builtin_amdgcn_s_setprio(0); } while (0)
#define PG8_WAIT_V(n) asm volatile("s_waitcnt vmcnt(" #n ")" ::: "memory")
#define PG8_WAIT_L(n) asm volatile("s_waitcnt lgkmcnt(" #n ")" ::: "memory")
#define PG8_BAR __builtin_amdgcn_s_barrier()
#define PG8_SCHED __builtin_amdgcn_sched_barrier(0)
    Unit cur, nxt; int ui = 0;
    if (!S.next(0, cur)) return;
    f32x4 acc[2][2][4][2];
#pragma unroll
    for (int a = 0; a < 2; ++a)
#pragma unroll
        for (int b = 0; b < 2; ++b)
#pragma unroll
            for (int m = 0; m < 4; ++m)
#pragma unroll
                for (int n = 0; n < 2; ++n) acc[a][b][m][n] = (f32x4){0.f, 0.f, 0.f, 0.f};
    bf16x8 At[4][2], B0[2][2], B1[2][2];
    const char* cA = (const char*)g.A + (size_t)cur.pm * tstep; const char* cB = (const char*)g.Bt + (size_t)cur.pn * tstep;
    S.a_ready(cur);
    PG8_STAGE(PG8_SB(0, 0), cB, voffB); PG8_STAGE(PG8_SA(0, 0), cA, voffA); PG8_STAGE(PG8_SB(0, 1), cB + hstep, voffB); PG8_STAGE(PG8_SA(0, 1), cA + hstep, voffA);
    if (wr == 1) PG8_BAR;
    PG8_WAIT_V(4); PG8_BAR;
    PG8_STAGE(PG8_SB(1, 0), cB + kstep, voffB); PG8_STAGE(PG8_SA(1, 0), cA + kstep, voffA); PG8_STAGE(PG8_SB(1, 1), cB + hstep + kstep, voffB);
    PG8_WAIT_V(6); PG8_BAR;
    PG8_STAMP();
    for (;;) {
        const bool has_next = S.next(ui + 1, nxt);
        const char* nA = has_next ? (const char*)g.A + (size_t)nxt.pm * tstep : cA; const char* nB = has_next ? (const char*)g.Bt + (size_t)nxt.pn * tstep : cB;
        for (int t = 0; t < nt; t += 2) {
            const bool last = (t == nt - 2);
            const char* a1 = cA + (size_t)(t + 1) * kstep;
            const char* a2 = last ? nA : cA + (size_t)(t + 2) * kstep; const char* b2 = last ? nB : cB + (size_t)(t + 2) * kstep;
            const char* a3 = a2 + kstep; const char* b3 = b2 + kstep;
            if (last && has_next) S.a_ready(nxt);
            PG8_LDB(B0, 0, 0); PG8_SCHED; PG8_LDA(At, 0, 0); PG8_STAGE(PG8_SA(1, 1), a1 + hstep, voffA);
            PG8_WAIT_L(8); PG8_BAR; PG8_WAIT_L(0); PG8_MMA(0, 0, At, B0); PG8_BAR; PG8_SCHED;
            PG8_LDB(B1, 0, 1); PG8_STAGE(PG8_SB(0, 0), b2, voffB);
            PG8_BAR; PG8_WAIT_L(0); PG8_MMA(0, 1, At, B1); PG8_BAR;
            PG8_LDA(At, 0, 1); PG8_STAGE(PG8_SA(0, 0), a2, voffA);
            PG8_BAR; PG8_WAIT_L(0); PG8_MMA(1, 0, At, B0); PG8_BAR; PG8_SCHED;
            PG8_STAGE(PG8_SB(0, 1), b2 + hstep, voffB);
            PG8_WAIT_V(6); PG8_BAR; PG8_MMA(1, 1, At, B1); PG8_BAR;
            PG8_LDB(B0, 1, 0); PG8_SCHED; PG8_LDA(At, 1, 0); PG8_STAGE(PG8_SA(0, 1), a2 + hstep, voffA);
            PG8_WAIT_L(8); PG8_BAR; PG8_WAIT_L(0); PG8_MMA(0, 0, At, B0); PG8_BAR; PG8_SCHED;
            PG8_LDB(B1, 1, 1); PG8_STAGE(PG8_SB(1, 0), b3, voffB);
            PG8_BAR; PG8_WAIT_L(0); PG8_MMA(0, 1, At, B1); PG8_BAR;
            PG8_LDA(At, 1, 1); PG8_STAGE(PG8_SA(1, 0), a3, voffA);
            PG8_BAR; PG8_WAIT_L(0); PG8_MMA(1, 0, At, B0); PG8_BAR; PG8_SCHED;
            PG8_STAGE(PG8_SB(1, 1), b3 + hstep, voffB);
            PG8_WAIT_V(6); PG8_BAR; PG8_MMA(1, 1, At, B1); PG8_BAR;
        }
        PG8_STAMP();
        if constexpr (!Epi::AFTER_DRAIN) { E(acc, cur, wr, wc, fr, fq); S.done(cur); }
        PG8_STAMP();
        if (!has_next) break;
#pragma unroll
        for (int a = 0; a < 2; ++a)
#pragma unroll
            for (int b = 0; b < 2; ++b)
#pragma unroll
                for (int m = 0; m < 4; ++m)
#pragma unroll
                    for (int n = 0; n < 2; ++n) acc[a][b][m][n] = (f32x4){0.f, 0.f, 0.f, 0.f};
        cur = nxt; cA = nA; cB = nB; ++ui;
    }
    PG8_WAIT_V(0);
    if (wr == 0) PG8_BAR;
    PG8_BAR;
    if constexpr (Epi::AFTER_DRAIN) { E.fused(acc, cur, wr, wc, fr, fq, lds, wid, lane); S.done(cur); }
    PG8_STAMP();
    if (STAMP && wid == 0) { stamps[lane] = lane < nts ? (((unsigned long long)(unsigned)ts_hi << 32) | (unsigned)ts_lo) : 0ull;
        if (lane == 62) stamps[62] = rt_entry; if (lane == 63) stamps[63] = (unsigned long long)wall_clock64(); }
#undef PG8_STAMP
#undef PG8_SA
#undef PG8_SB
#undef PG8_STAGE
#undef PG8_LDA
#undef PG8_LDB
#undef PG8_MMA
#undef PG8_WAIT_V
#undef PG8_WAIT_L
#undef PG8_BAR
#undef PG8_SCHED
}
}

using pg8::bf16_t; using pg8::bf16x8; using pg8::f32x4; using pg8::u32x4;
typedef unsigned u32x2 __attribute__((ext_vector_type(2)));
#define LDS_WAIT() asm volatile("s_waitcnt lgkmcnt(0)" ::: "memory")
#define MFMA16(a, b, c) __builtin_amdgcn_mfma_f32_16x16x32_bf16((a), (b), (c), 0, 0, 0)

constexpr int D = 1024, NB = 8, T = 2048, DEPTH = 4, SB = 128;
constexpr int MP = NB * T;
constexpr int MV = MP + SB;
constexpr int MPAD = 16640;
constexpr int QKVD = 1536, NIN = 3080, NINP = 3328, DFF = 2816, NUP = 5632, NMOD = 6144, MODLD = DEPTH * NMOD;
constexpr int PC_Z = 1536, PC_U = 2048, PC_VB = 2560, PC_BETA = 3072, PC_ALPHA = 3076;
constexpr float EPS = 1e-6f;
constexpr int NWAVES = 8, NTHR = 512;
constexpr int LDS_BYTES = 160 * 1024;

constexpr size_t MiB = 1u << 20;
constexpr size_t WS_W = 1 * MiB;
constexpr size_t WL_IN = 0, WL_OUT = (size_t)NINP * D * 2, WL_UP = WL_OUT + (size_t)D * D * 2, WL_DOWN = WL_UP + (size_t)NUP * D * 2, WL_STRIDE = WL_DOWN + (size_t)D * DFF * 2;
static_assert(WL_STRIDE == 25 * MiB, "weight stride");
constexpr size_t WS_MOD = WS_W + 4 * WL_STRIDE;
constexpr size_t WS_XR = WS_MOD + 13 * MiB;
constexpr size_t WS_AB = WS_XR + 65 * MiB;
constexpr size_t WS_BIG = WS_AB + 33 * MiB;
constexpr size_t WS_OBUF = WS_BIG + 106 * MiB;
constexpr size_t WS_ACT = WS_BIG + 179 * MiB;
constexpr size_t WS_WMODT = WS_ACT;
constexpr size_t WS_CACT = WS_ACT + 48 * MiB;
constexpr size_t WS_END = WS_ACT + 90 * MiB;
static_assert((size_t)136 * MODLD * 4 <= 13 * MiB && (size_t)MPAD * D * 4 <= 65 * MiB && (size_t)MPAD * D * 2 <= 33 * MiB, "ws map");
static_assert((size_t)MPAD * NINP * 2 <= 106 * MiB && (size_t)MPAD * NUP * 2 <= 179 * MiB && (size_t)MPAD * DFF * 2 <= 90 * MiB, "ws map 2");
constexpr int DR_NW = 0, DR_QG = 17408, DR_QK = 34816, DR_KDT = 44032, DR_UT = 62464, DR_EG = 80896, DR_STRIDE = 81152;
static_assert((size_t)1024 * DR_STRIDE <= 90 * MiB, "dr");

constexpr size_t O_Y = 0, O_DP = 16908288, O_DS = 19005440, O_QP = 52559872, O_QS = 52707328, O_FP = 55066624, O_FS = 55427072, O_SV = 61194240, O_END = 61456384;

__device__ __forceinline__ float bf2f(unsigned short b) { return __uint_as_float(((unsigned)b) << 16); }
__device__ __forceinline__ unsigned f2bf(float f) { unsigned u = __float_as_uint(f); return (u + 0x7fffu + ((u >> 16) & 1u)) >> 16; }
__device__ __forceinline__ unsigned pk2(float lo, float hi) { return f2bf(lo) | (f2bf(hi) << 16); }
__device__ __forceinline__ float lo_f(unsigned w) { return __uint_as_float(w << 16); }
__device__ __forceinline__ float hi_f(unsigned w) { return __uint_as_float(w & 0xffff0000u); }
__device__ __forceinline__ float silu_f(float x) { return x / (1.f + __expf(-x)); }
__device__ __forceinline__ float gelu_f(float x) { const float y = 0.7978845608028654f * (x + 0.044715f * x * x * x); const float th = 1.f - 2.f / (__expf(2.f * y) + 1.f); return 0.5f * x * (1.f + th); }
__device__ __forceinline__ float softplus_f(float x) { return x > 20.f ? x : log1pf(__expf(x)); }
__device__ __forceinline__ float wave_sum(float v) {
#pragma unroll
    for (int o = 1; o < 64; o <<= 1) v += __shfl_xor(v, o);
    return v;
}
__device__ __forceinline__ float sum16(float v) { v += __shfl_xor(v, 1); v += __shfl_xor(v, 2); v += __shfl_xor(v, 4); v += __shfl_xor(v, 8); return v; }
__device__ __forceinline__ void unpack8(const u32x4 v, float (&x)[8]) { x[0] = lo_f(v.x); x[1] = hi_f(v.x); x[2] = lo_f(v.y); x[3] = hi_f(v.y); x[4] = lo_f(v.z); x[5] = hi_f(v.z); x[6] = lo_f(v.w); x[7] = hi_f(v.w); }
__device__ __forceinline__ u32x4 pack8(const float (&x)[8]) { u32x4 o; o.x = pk2(x[0], x[1]); o.y = pk2(x[2], x[3]); o.z = pk2(x[4], x[5]); o.w = pk2(x[6], x[7]); return o; }
__device__ __forceinline__ int mod_row(int m) { return m < MP ? (m >> 11) : (8 + m - MP); }

struct EpiMod {
    static constexpr bool PERM = false, AFTER_DRAIN = false;
    float* C; const float* bias;
    __device__ __forceinline__ void operator()(const f32x4 (&acc)[2][2][4][2], const pg8::Unit& u, int wr, int wc, int fr, int fq) const {
        const int row0 = u.pm * 256 + wr * 64 + fr, col0 = u.pn * 256 + wc * 32 + 4 * fq;
#pragma unroll
        for (int ai = 0; ai < 2; ++ai)
#pragma unroll
            for (int m = 0; m < 4; ++m) { const int row = row0 + ai * 128 + m * 16;
                if (row < 136) {
#pragma unroll
                    for (int bj = 0; bj < 2; ++bj)
#pragma unroll
                        for (int n = 0; n < 2; ++n) { const int col = col0 + bj * 128 + n * 16; *(f32x4*)(C + (size_t)row * MODLD + col) = acc[ai][bj][m][n] + *(const f32x4*)(bias + col); } } }
    }
};
struct EpiBf {
    static constexpr bool PERM = true, AFTER_DRAIN = false;
    bf16_t* O; int ldc;
    __device__ __forceinline__ void operator()(const f32x4 (&acc)[2][2][4][2], const pg8::Unit& u, int wr, int wc, int fr, int fq) const {
        const int row0 = u.pm * 256 + wr * 64 + fr, col0 = u.pn * 256 + wc * 32 + 8 * fq;
#pragma unroll
        for (int ai = 0; ai < 2; ++ai)
#pragma unroll
            for (int m = 0; m < 4; ++m) { bf16_t* rowp = O + (size_t)(row0 + ai * 128 + m * 16) * ldc + col0;
#pragma unroll
                for (int bj = 0; bj < 2; ++bj) { const f32x4 v0 = acc[ai][bj][m][0], v1 = acc[ai][bj][m][1];
                    u32x4 w; w.x = pg8::cvt_pk_bf16(v0[0], v0[1]); w.y = pg8::cvt_pk_bf16(v0[2], v0[3]); w.z = pg8::cvt_pk_bf16(v1[0], v1[1]); w.w = pg8::cvt_pk_bf16(v1[2], v1[3]);
                    *(u32x4*)(rowp + bj * 128) = w; } }
    }
};
struct EpiRes {
    static constexpr bool PERM = false, AFTER_DRAIN = false;
    float* X; const float* gate;
    __device__ __forceinline__ void operator()(const f32x4 (&acc)[2][2][4][2], const pg8::Unit& u, int wr, int wc, int fr, int fq) const {
        const int row0 = u.pm * 256 + wr * 64 + fr, col0 = u.pn * 256 + wc * 32 + 4 * fq;
#pragma unroll
        for (int ai = 0; ai < 2; ++ai)
#pragma unroll
            for (int m = 0; m < 4; ++m) { const int row = row0 + ai * 128 + m * 16;
                if (row < MV) { const float* gp = gate + (size_t)mod_row(row) * MODLD; float* xp = X + (size_t)row * D;
#pragma unroll
                    for (int bj = 0; bj < 2; ++bj)
#pragma unroll
                        for (int n = 0; n < 2; ++n) { const int col = col0 + bj * 128 + n * 16; const f32x4 g = *(const f32x4*)(gp + col); const f32x4 x = *(const f32x4*)(xp + col); *(f32x4*)(xp + col) = x + g * acc[ai][bj][m][n]; } } }
    }
};

__device__ __forceinline__ void tr_item(const float* W, int ldw, int K, int nblk, bf16_t* WT, float* scr, int item, int lane) {
    const int kb = item / nblk, nb = item % nblk, k0 = 64 * kb, n0 = 32 * nb;
#pragma unroll 8
    for (int i = 0; i < 32; ++i) { const int kk = 2 * i + (lane >> 5); scr[kk * 33 + (lane & 31)] = W[(size_t)(k0 + kk) * ldw + n0 + (lane & 31)]; }
    LDS_WAIT();
    const int c = lane & 7;
#pragma unroll
    for (int j = 0; j < 4; ++j) { const int n = (lane >> 3) + 8 * j; const float* s = scr + (8 * c) * 33 + n;
        u32x4 o; o.x = pk2(s[0 * 33], s[1 * 33]); o.y = pk2(s[2 * 33], s[3 * 33]); o.z = pk2(s[4 * 33], s[5 * 33]); o.w = pk2(s[6 * 33], s[7 * 33]);
        *(u32x4*)(WT + (size_t)(n0 + n) * K + k0 + 8 * c) = o; }
    LDS_WAIT();
}
constexpr int CV_PER_LAYER = 1024 + 256 + 256 + 264 + 512 + 2816 + 1408 + 3072;

__device__ __forceinline__ void phase_convert(unsigned char* lds, unsigned char* ws, const float* w_in, const float* w_out, const float* w_up, const float* w_down, const float* w_mod,
                                              const float* c_prompt, const float* c_sample, int gw, int ngw, int wave, int lane) {
    float* scr = (float*)(lds + wave * 16384);
    for (int it = gw; it < DEPTH * CV_PER_LAYER; it += ngw) {
        const int l = it / CV_PER_LAYER; int r = it % CV_PER_LAYER;
        const float* win = w_in + (size_t)l * D * NIN;
        bf16_t* wl = (bf16_t*)(ws + WS_W + l * WL_STRIDE);
        bf16_t* wint = wl;
        if (r < 1024) { tr_item(win, NIN, D, 64, wint, scr, r, lane); continue; } r -= 1024;
        if (r < 256) { tr_item(win + 2056, NIN, D, 16, wint + (size_t)PC_U * D, scr, r, lane); continue; } r -= 256;
        if (r < 256) { tr_item(win + 2568, NIN, D, 16, wint + (size_t)PC_VB * D, scr, r, lane); continue; } r -= 256;
        if (r < 264) {
            if (r < 16) { const int k = 64 * r + lane;
#pragma unroll
                for (int n = 0; n < 8; ++n) wint[(size_t)(PC_BETA + n) * D + k] = (bf16_t)f2bf(win[(size_t)k * NIN + 2048 + n]); }
            else { u32x4* z = (u32x4*)(wint + (size_t)(NIN + (r - 16)) * D); const u32x4 zero = {0u, 0u, 0u, 0u}; z[lane] = zero; z[lane + 64] = zero; }
            continue; } r -= 264;
        if (r < 512) { tr_item(w_out + (size_t)l * D * D, D, D, 32, (bf16_t*)((unsigned char*)wl + WL_OUT), scr, r, lane); continue; } r -= 512;
        if (r < 2816) { tr_item(w_up + (size_t)l * D * NUP, NUP, D, 176, (bf16_t*)((unsigned char*)wl + WL_UP), scr, r, lane); continue; } r -= 2816;
        if (r < 1408) { tr_item(w_down + (size_t)l * DFF * D, D, DFF, 32, (bf16_t*)((unsigned char*)wl + WL_DOWN), scr, r, lane); continue; } r -= 1408;
        tr_item(w_mod + (size_t)l * D * NMOD, NMOD, D, 192, (bf16_t*)(ws + WS_WMODT) + (size_t)l * NMOD * D, scr, r, lane);
    }
    bf16_t* cact = (bf16_t*)(ws + WS_CACT);
    for (int idx = gw * 64 + lane; idx < 256 * 128; idx += ngw * 64) {
        const int row = idx >> 7, c8 = (idx & 127) * 8; u32x4 o = {0u, 0u, 0u, 0u};
        if (row < 136) { const float* src = row < 8 ? c_prompt + (size_t)row * D + c8 : c_sample + (size_t)(row - 8) * D + c8;
            const f32x4 a = *(const f32x4*)src, b = *(const f32x4*)(src + 4);
            o.x = pk2(silu_f(a.x), silu_f(a.y)); o.y = pk2(silu_f(a.z), silu_f(a.w)); o.z = pk2(silu_f(b.x), silu_f(b.y)); o.w = pk2(silu_f(b.z), silu_f(b.w)); }
        *(u32x4*)(cact + (size_t)row * D + c8) = o;
    }
}

__device__ __forceinline__ void phase_ln(const float* xa, const float* xb, const float* nw, const float* sh, const float* sc, bf16_t* out, float* xr_copy, int gw, int ngw, int lane) {
    for (int m = gw; m < MPAD; m += ngw) {
        u32x2* o8 = (u32x2*)(out + (size_t)m * D) + lane;
        if (m >= MV) { const u32x2 z = {0u, 0u};
#pragma unroll
            for (int j = 0; j < 4; ++j) o8[64 * j] = z;
            continue; }
        const float* xrow = m < MP ? xa + (size_t)m * D : xb + (size_t)(m - MP) * D;
        const int mr = mod_row(m);
        const f32x4* xr = (const f32x4*)xrow + lane;
        f32x4 v[4]; float s = 0.f;
#pragma unroll
        for (int j = 0; j < 4; ++j) { v[j] = xr[64 * j]; s += (v[j].x * v[j].x + v[j].y * v[j].y) + (v[j].z * v[j].z + v[j].w * v[j].w); }
        s = wave_sum(s);
        const float rstd = rsqrtf(s * (1.f / D) + EPS);
#pragma unroll
        for (int j = 0; j < 4; ++j) { const int c = 4 * lane + 256 * j;
            const f32x4 w = *(const f32x4*)(nw + c), s1 = *(const f32x4*)(sc + (size_t)mr * MODLD + c), s0 = *(const f32x4*)(sh + (size_t)mr * MODLD + c);
            const f32x4 h = v[j] * rstd * w * (s1 + 1.f) + s0;
            u32x2 o; o.x = pk2(h.x, h.y); o.y = pk2(h.z, h.w); o8[64 * j] = o;
            if (xr_copy) *((f32x4*)(xr_copy + (size_t)m * D) + lane + 64 * j) = v[j]; }
    }
}
__device__ __forceinline__ void phase_final(const float* X, const float* fw, float* out, int gw, int ngw, int lane) {
    for (int m = gw; m < MV; m += ngw) {
        const f32x4* xr = (const f32x4*)(X + (size_t)m * D) + lane;
        f32x4 v[4]; float s = 0.f;
#pragma unroll
        for (int j = 0; j < 4; ++j) { v[j] = xr[64 * j]; s += (v[j].x * v[j].x + v[j].y * v[j].y) + (v[j].z * v[j].z + v[j].w * v[j].w); }
        s = wave_sum(s);
        const float rstd = rsqrtf(s * (1.f / D) + EPS);
#pragma unroll
        for (int j = 0; j < 4; ++j) { const int c = 4 * lane + 256 * j; const f32x4 w = *(const f32x4*)(fw + c); *((f32x4*)(out + (size_t)m * D) + lane + 64 * j) = v[j] * rstd * w; }
    }
}

__device__ __forceinline__ void prep_item(unsigned char* lds, const bf16_t* P, const float* cw, float alog, float dtb, unsigned char* dr, float* qkvconv_out, int b, int ci, int h, int tid) {
    bf16_t* sKn = (bf16_t*)lds; bf16_t* sKB = (bf16_t*)(lds + 17408); bf16_t* sQ = (bf16_t*)(lds + 34816);
    float* sRhs = (float*)(lds + 52224); float* sL = (float*)(lds + 117760); float* sBeta = (float*)(lds + 135168); float* sGc = (float*)(lds + 135424);
    const int lane = tid & 63, wid = __builtin_amdgcn_readfirstlane(tid >> 6);
    const size_t m0 = (size_t)b * T + (size_t)ci * 64;
    if (tid < 64) {
        const bf16_t* pr = P + (m0 + tid) * NINP;
        const float braw = bf2f(pr[PC_BETA + h]), araw = bf2f(pr[PC_ALPHA + h]);
        const float beta = 1.f / (1.f + __expf(-braw));
        float g = -__expf(alog) * softplus_f(araw + dtb);
#pragma unroll
        for (int off = 1; off < 64; off <<= 1) { const float v = __shfl_up(g, off); if (lane >= off) g += v; }
        sBeta[tid] = beta; sGc[tid] = g;
    }
    __syncthreads();
    const float gl = sGc[63];
#pragma unroll 1
    for (int i = 0; i < 6; ++i) {
        const int tensor = i >> 1, t = (tid >> 4) + 32 * (i & 1), grp = tid & 15;
        const int ch = tensor * 512 + h * 128 + grp * 8;
        const int tg = ci * 64 + t;
        float y[8];
#pragma unroll
        for (int e = 0; e < 8; ++e) y[e] = 0.f;
        u32x4 xcur = {0u, 0u, 0u, 0u};
#pragma unroll
        for (int j = 0; j < 4; ++j) {
            if (tg - 3 + j >= 0) {
                const u32x4 xv = *(const u32x4*)(P + (m0 + t - 3 + j) * NINP + ch);
                const f32x4 w0 = *(const f32x4*)(cw + j * QKVD + ch), w1 = *(const f32x4*)(cw + j * QKVD + ch + 4);
                float x[8]; unpack8(xv, x);
                y[0] += w0.x * x[0]; y[1] += w0.y * x[1]; y[2] += w0.z * x[2]; y[3] += w0.w * x[3];
                y[4] += w1.x * x[4]; y[5] += w1.y * x[5]; y[6] += w1.z * x[6]; y[7] += w1.w * x[7];
                if (j == 3) xcur = xv;
            }
        }
        if (qkvconv_out != nullptr && t >= 61) { float x[8]; unpack8(xcur, x); float* o = qkvconv_out + (size_t)(t - 61) * QKVD + ch;
            *(f32x4*)o = (f32x4){x[0], x[1], x[2], x[3]}; *(f32x4*)(o + 4) = (f32x4){x[4], x[5], x[6], x[7]}; }
        float ss = 0.f;
#pragma unroll
        for (int e = 0; e < 8; ++e) { y[e] = silu_f(y[e]); ss += y[e] * y[e]; }
        ss = sum16(ss);
        const float bt = sBeta[t], gc = sGc[t];
        if (tensor == 0) {
            const float rn = rsqrtf(ss + EPS) * 0.08838834764831845f;
#pragma unroll
            for (int e = 0; e < 8; ++e) y[e] *= rn;
            *(u32x4*)(sQ + t * 136 + grp * 8) = pack8(y);
            const float eg = __expf(gc);
#pragma unroll
            for (int e = 0; e < 8; ++e) y[e] *= eg;
            *(u32x4*)(dr + DR_QG + (t * 136 + grp * 8) * 2) = pack8(y);
        } else if (tensor == 1) {
            const float rn = rsqrtf(ss + EPS);
#pragma unroll
            for (int e = 0; e < 8; ++e) y[e] *= rn;
            *(u32x4*)(sKn + t * 136 + grp * 8) = pack8(y);
            const float kd = __expf(gl - gc);
            bf16_t* kdt = (bf16_t*)(dr + DR_KDT);
#pragma unroll
            for (int e = 0; e < 8; ++e) kdt[(grp * 8 + e) * 72 + t] = (bf16_t)f2bf(y[e] * kd);
#pragma unroll
            for (int e = 0; e < 8; ++e) y[e] *= bt;
            *(u32x4*)(sKB + t * 136 + grp * 8) = pack8(y);
            const float eg = __expf(gc);
            float* r = sRhs + t * 256 + 128 + grp * 8;
            *(f32x4*)r = (f32x4){y[0] * eg, y[1] * eg, y[2] * eg, y[3] * eg}; *(f32x4*)(r + 4) = (f32x4){y[4] * eg, y[5] * eg, y[6] * eg, y[7] * eg};
        } else {
            float* r = sRhs + t * 256 + grp * 8;
            *(f32x4*)r = (f32x4){y[0] * bt, y[1] * bt, y[2] * bt, y[3] * bt}; *(f32x4*)(r + 4) = (f32x4){y[4] * bt, y[5] * bt, y[6] * bt, y[7] * bt};
        }
    }
    __syncthreads();
    {
        const int rt = wid & 3, isqk = wid >> 2, fr = lane & 15, fq = lane >> 4;
        const bf16_t* asrc = isqk ? sQ : sKB;
        bf16x8 a[4];
#pragma unroll
        for (int ks = 0; ks < 4; ++ks) a[ks] = *(const bf16x8*)(asrc + (16 * rt + fr) * 136 + ks * 32 + fq * 8);
        bf16_t* qkg = (bf16_t*)(dr + DR_QK);
#pragma unroll
        for (int ct = 0; ct < 4; ++ct) {
            f32x4 acc = {0.f, 0.f, 0.f, 0.f};
            if (ct <= rt) {
#pragma unroll
                for (int ks = 0; ks < 4; ++ks) { const bf16x8 bb = *(const bf16x8*)(sKn + (16 * ct + fr) * 136 + ks * 32 + fq * 8); acc = MFMA16(a[ks], bb, acc); }
            }
            const int j = 16 * ct + fr; const float gj = sGc[j];
#pragma unroll
            for (int jj = 0; jj < 4; ++jj) { const int i = 16 * rt + 4 * fq + jj; const float d = __expf(fminf(sGc[i] - gj, 0.f));
                if (!isqk) { if (ct <= rt) sL[i * 68 + j] = (j < i) ? acc[jj] * d : 0.f; }
                else { const float v = (j <= i) ? acc[jj] * d : 0.f; qkg[i * 72 + j] = (bf16_t)f2bf(v); } }
        }
    }
    __syncthreads();
    if (wid < 4) {
        const int col = wid * 64 + lane;
        int vz; asm volatile("v_mov_b32 %0, 0" : "=v"(vz));
        const float* sLv = sL + vz;
        float sol[64];
#pragma unroll
        for (int i = 0; i < 64; ++i) sol[i] = sRhs[i * 256 + col];
#pragma unroll
        for (int i = 1; i < 64; ++i) { float a0 = sol[i], a1 = 0.f;
#pragma unroll
            for (int j = 0; j < i; ++j) { const float lij = sLv[i * 68 + j]; if (j & 1) a1 -= lij * sol[j]; else a0 -= lij * sol[j]; }
            sol[i] = a0 + a1; }
        if (wid < 2) { u32x4* dst = (u32x4*)(dr + DR_UT + col * 144);
#pragma unroll
            for (int q = 0; q < 8; ++q) { u32x4 o; o.x = pk2(sol[8 * q], sol[8 * q + 1]); o.y = pk2(sol[8 * q + 2], sol[8 * q + 3]); o.z = pk2(sol[8 * q + 4], sol[8 * q + 5]); o.w = pk2(sol[8 * q + 6], sol[8 * q + 7]); dst[q] = o; } }
        else { bf16_t* nw = (bf16_t*)(dr + DR_NW); const int k = col - 128;
#pragma unroll
            for (int i = 0; i < 64; ++i) nw[i * 136 + k] = (bf16_t)f2bf(-sol[i]); }
    }
    if (tid == 0) *(float*)(dr + DR_EG) = __expf(gl);
    __syncthreads();
}

__device__ __forceinline__ void sgu_item(unsigned char* lds, const bf16_t* P, const float* Wl, const float* bl, const float* nl, bf16_t* MIX, int b, int n, int h, int tid) {
    bf16_t* sW = (bf16_t*)lds; bf16_t* sVt = (bf16_t*)(lds + 34816);
    const int lane = tid & 63, wid = __builtin_amdgcn_readfirstlane(tid >> 6);
    const size_t m0 = (size_t)b * T + (size_t)n * 128;
    { const int i = tid >> 2, j0 = (tid & 3) * 32;
#pragma unroll
      for (int q = 0; q < 4; ++q) { const f32x4 w0 = *(const f32x4*)(Wl + i * 128 + j0 + 8 * q), w1 = *(const f32x4*)(Wl + i * 128 + j0 + 8 * q + 4);
          float x[8] = {w0.x, w0.y, w0.z, w0.w, w1.x, w1.y, w1.z, w1.w};
#pragma unroll
          for (int e = 0; e < 8; ++e) x[e] = (j0 + 8 * q + e <= i) ? x[e] : 0.f;
          *(u32x4*)(sW + i * 136 + j0 + 8 * q) = pack8(x); } }
#pragma unroll 1
    for (int r = 0; r < 4; ++r) { const int j = (tid >> 4) + 32 * r, grp = tid & 15;
        const u32x4 xv = *(const u32x4*)(P + (m0 + j) * NINP + PC_VB + h * 128 + grp * 8);
        float x[8]; unpack8(xv, x); float ss = 0.f;
#pragma unroll
        for (int e = 0; e < 8; ++e) { x[e] = gelu_f(x[e]); ss += x[e] * x[e]; }
        ss = sum16(ss);
        const float rn = rsqrtf(ss * (1.f / 128.f) + EPS);
        const f32x4 n0 = *(const f32x4*)(nl + grp * 8), n1 = *(const f32x4*)(nl + grp * 8 + 4);
        const float nn[8] = {n0.x, n0.y, n0.z, n0.w, n1.x, n1.y, n1.z, n1.w};
#pragma unroll
        for (int e = 0; e < 8; ++e) sVt[(grp * 8 + e) * 136 + j] = (bf16_t)f2bf(x[e] * rn * nn[e]); }
    __syncthreads();
    { const int fr = lane & 15, fq = lane >> 4;
      f32x4 acc[8];
#pragma unroll
      for (int dt = 0; dt < 8; ++dt) acc[dt] = (f32x4){0.f, 0.f, 0.f, 0.f};
      for (int ks = 0; ks <= (wid >> 1); ++ks) {
          const bf16x8 a = *(const bf16x8*)(sW + (16 * wid + fr) * 136 + 32 * ks + 8 * fq);
#pragma unroll
          for (int dt = 0; dt < 8; ++dt) { const bf16x8 bb = *(const bf16x8*)(sVt + (16 * dt + fr) * 136 + 32 * ks + 8 * fq); acc[dt] = MFMA16(bb, a, acc[dt]); } }
      const int i = 16 * wid + fr; const float bi = bl[i]; const size_t m = m0 + i;
#pragma unroll
      for (int dt = 0; dt < 8; ++dt) { const int d = 16 * dt + 4 * fq;
          const u32x2 uv = *(const u32x2*)(P + m * NINP + PC_U + h * 128 + d);
          const float u0 = gelu_f(lo_f(uv.x)), u1 = gelu_f(hi_f(uv.x)), u2 = gelu_f(lo_f(uv.y)), u3 = gelu_f(hi_f(uv.y));
          u32x2 o; o.x = pk2(u0 * (acc[dt][0] + bi), u1 * (acc[dt][1] + bi)); o.y = pk2(u2 * (acc[dt][2] + bi), u3 * (acc[dt][3] + bi));
          *(u32x2*)(MIX + m * D + 512 + h * 128 + d) = o; } }
    __syncthreads();
}

__device__ __forceinline__ void sample_item(unsigned char* lds, const bf16_t* P, const float* cw, float alog, float dtb, const float* stq, const float* S0, float* S1, float* qkvconv_out,
                                            float* sguv_out, const float* gdn, const float* sgn, float w00, float b0, bf16_t* MIX, int b, int h, int tid) {
    float* sq = (float*)lds; float* sk = sq + 128; float* sv = sq + 256; float* svn = sq + 384; float* so = sq + 512; float* ssc = sq + 640; float* redk = sq + 656; float* redq = redk + 2048;
    const int lane = tid & 63;
    const size_t m = (size_t)MP + b; const bf16_t* pr = P + m * NINP;
    if (tid < 64) {
        const int tensor = tid >> 4, grp = tid & 15; const bool act = tensor < 3;
        const int ch = (act ? tensor : 0) * 512 + h * 128 + grp * 8;
        float x[8]; unpack8(*(const u32x4*)(pr + ch), x);
        float y[8];
        { const f32x4 w0 = *(const f32x4*)(cw + 3 * QKVD + ch), w1 = *(const f32x4*)(cw + 3 * QKVD + ch + 4);
          y[0] = w0.x * x[0]; y[1] = w0.y * x[1]; y[2] = w0.z * x[2]; y[3] = w0.w * x[3]; y[4] = w1.x * x[4]; y[5] = w1.y * x[5]; y[6] = w1.z * x[6]; y[7] = w1.w * x[7]; }
#pragma unroll
        for (int r = 0; r < 3; ++r) { const f32x4 s0 = *(const f32x4*)(stq + r * QKVD + ch), s1 = *(const f32x4*)(stq + r * QKVD + ch + 4);
            const f32x4 w0 = *(const f32x4*)(cw + r * QKVD + ch), w1 = *(const f32x4*)(cw + r * QKVD + ch + 4);
            y[0] += w0.x * s0.x; y[1] += w0.y * s0.y; y[2] += w0.z * s0.z; y[3] += w0.w * s0.w; y[4] += w1.x * s1.x; y[5] += w1.y * s1.y; y[6] += w1.z * s1.z; y[7] += w1.w * s1.w;
            if (act && r >= 1) { *(f32x4*)(qkvconv_out + (r - 1) * QKVD + ch) = s0; *(f32x4*)(qkvconv_out + (r - 1) * QKVD + ch + 4) = s1; } }
        if (act) { *(f32x4*)(qkvconv_out + 2 * QKVD + ch) = (f32x4){x[0], x[1], x[2], x[3]}; *(f32x4*)(qkvconv_out + 2 * QKVD + ch + 4) = (f32x4){x[4], x[5], x[6], x[7]}; }
        float ss = 0.f;
#pragma unroll
        for (int e = 0; e < 8; ++e) { y[e] = silu_f(y[e]); ss += y[e] * y[e]; }
        ss = sum16(ss);
        float rn = 1.f;
        if (tensor == 0) rn = rsqrtf(ss + EPS) * 0.08838834764831845f; else if (tensor == 1) rn = rsqrtf(ss + EPS);
        if (act) { float* dst = tensor == 0 ? sq : (tensor == 1 ? sk : sv);
#pragma unroll
            for (int e = 0; e < 8; ++e) dst[grp * 8 + e] = y[e] * rn; }
        if (tid == 0) { const float braw = bf2f(pr[PC_BETA + h]), araw = bf2f(pr[PC_ALPHA + h]); ssc[0] = 1.f / (1.f + __expf(-braw)); ssc[1] = __expf(-__expf(alog) * softplus_f(araw + dtb)); }
    }
    __syncthreads();
    const float beta = ssc[0], eg = ssc[1];
    const int dv4 = (tid & 31) * 4, kr = tid >> 5;
    f32x4 s0[8]; f32x4 pk = {0.f, 0.f, 0.f, 0.f}, pq = {0.f, 0.f, 0.f, 0.f};
#pragma unroll
    for (int r = 0; r < 8; ++r) { const int kk = kr + 16 * r; s0[r] = *(const f32x4*)(S0 + kk * 128 + dv4); pk += s0[r] * sk[kk]; pq += s0[r] * sq[kk]; }
    *(f32x4*)(redk + kr * 128 + dv4) = pk; *(f32x4*)(redq + kr * 128 + dv4) = pq;
    __syncthreads();
    if (tid < 128) { float kS = 0.f, qS = 0.f, qk = 0.f;
#pragma unroll
        for (int r = 0; r < 16; ++r) { kS += redk[r * 128 + tid]; qS += redq[r * 128 + tid]; }
        for (int d = 0; d < 128; ++d) qk += sq[d] * sk[d];
        const float vn = beta * (sv[tid] - eg * kS); svn[tid] = vn; so[tid] = eg * qS + qk * vn; }
    __syncthreads();
    { const f32x4 vn4 = *(const f32x4*)(svn + dv4);
#pragma unroll
      for (int r = 0; r < 8; ++r) { const int kk = kr + 16 * r; *(f32x4*)(S1 + kk * 128 + dv4) = s0[r] * eg + vn4 * sk[kk]; } }
    if (tid < 64) { const int d0 = 2 * lane; const float o0 = so[d0], o1 = so[d0 + 1];
        const float ss = wave_sum(o0 * o0 + o1 * o1); const float rn = rsqrtf(ss * (1.f / 128.f) + EPS);
        const unsigned zz = *(const unsigned*)(pr + PC_Z + h * 128 + d0);
        *(unsigned*)(MIX + m * D + h * 128 + d0) = pk2(o0 * rn * gdn[d0] * silu_f(lo_f(zz)), o1 * rn * gdn[d0 + 1] * silu_f(hi_f(zz))); }
    else if (tid < 128) { const int d0 = 2 * lane; const unsigned vb = *(const unsigned*)(pr + PC_VB + h * 128 + d0);
        const float g0 = gelu_f(lo_f(vb)), g1 = gelu_f(hi_f(vb));
        const float ss = wave_sum(g0 * g0 + g1 * g1); const float rn = rsqrtf(ss * (1.f / 128.f) + EPS);
        const float v0 = g0 * rn * sgn[d0], v1 = g1 * rn * sgn[d0 + 1];
        sguv_out[d0] = v0; sguv_out[d0 + 1] = v1;
        const unsigned uu = *(const unsigned*)(pr + PC_U + h * 128 + d0);
        *(unsigned*)(MIX + m * D + 512 + h * 128 + d0) = pk2(gelu_f(lo_f(uu)) * (w00 * v0 + b0), gelu_f(hi_f(uu)) * (w00 * v1 + b0)); }
    __syncthreads();
}

__device__ __forceinline__ bf16x8 ld2(const bf16_t* p0, const bf16_t* p1) { const u32x2 a = *(const u32x2*)p0, b = *(const u32x2*)p1; u32x4 r; r.x = a.x; r.y = a.y; r.z = b.x; r.w = b.y; return __builtin_bit_cast(bf16x8, r); }
__device__ __forceinline__ bf16x8 packacc(const f32x4 a, const f32x4 b) { u32x4 r; r.x = pk2(a[0], a[1]); r.y = pk2(a[2], a[3]); r.z = pk2(b[0], b[1]); r.w = pk2(b[2], b[3]); return __builtin_bit_cast(bf16x8, r); }
__device__ __forceinline__ void scan_item(const unsigned char* drbase, float* OBUF, float* Sout, int item, int lane) {
    const int bh = item >> 3, cs = item & 7, b = bh >> 2, h = bh & 3, dv0 = 16 * cs, fr = lane & 15, fq = lane >> 4;
    f32x4 S[8];
#pragma unroll
    for (int kt = 0; kt < 8; ++kt) S[kt] = (f32x4){0.f, 0.f, 0.f, 0.f};
#pragma unroll 1
    for (int ci = 0; ci < 32; ++ci) {
        const unsigned char* dr = drbase + (size_t)((b * 32 + ci) * 4 + h) * DR_STRIDE;
        const bf16_t* NW = (const bf16_t*)(dr + DR_NW); const bf16_t* QG = (const bf16_t*)(dr + DR_QG); const bf16_t* QK = (const bf16_t*)(dr + DR_QK);
        const bf16_t* KDT = (const bf16_t*)(dr + DR_KDT); const bf16_t* UT = (const bf16_t*)(dr + DR_UT);
        const float eg = *(const float*)(dr + DR_EG);
        f32x4 vn[4], o[4];
#pragma unroll
        for (int it = 0; it < 4; ++it) { const u32x2 uv = *(const u32x2*)(UT + (dv0 + fr) * 72 + 16 * it + 4 * fq); vn[it] = (f32x4){lo_f(uv.x), hi_f(uv.x), lo_f(uv.y), hi_f(uv.y)}; o[it] = (f32x4){0.f, 0.f, 0.f, 0.f}; }
        bf16x8 sb[4];
#pragma unroll
        for (int kp = 0; kp < 4; ++kp) sb[kp] = packacc(S[2 * kp], S[2 * kp + 1]);
#pragma unroll
        for (int it = 0; it < 4; ++it)
#pragma unroll
            for (int kp = 0; kp < 4; ++kp) { const int off = (16 * it + fr) * 136 + 32 * kp + 4 * fq;
                vn[it] = MFMA16(ld2(NW + off, NW + off + 16), sb[kp], vn[it]);
                o[it] = MFMA16(ld2(QG + off, QG + off + 16), sb[kp], o[it]); }
        bf16x8 vb[2];
#pragma unroll
        for (int p = 0; p < 2; ++p) vb[p] = packacc(vn[2 * p], vn[2 * p + 1]);
#pragma unroll
        for (int it = 0; it < 4; ++it)
#pragma unroll
            for (int p = 0; p < 2; ++p) { const int off = (16 * it + fr) * 72 + 32 * p + 4 * fq; o[it] = MFMA16(ld2(QK + off, QK + off + 16), vb[p], o[it]); }
#pragma unroll
        for (int kt = 0; kt < 8; ++kt) { S[kt] = S[kt] * eg;
#pragma unroll
            for (int p = 0; p < 2; ++p) { const int off = (16 * kt + fr) * 72 + 32 * p + 4 * fq; S[kt] = MFMA16(ld2(KDT + off, KDT + off + 16), vb[p], S[kt]); } }
        float* ob = OBUF + ((size_t)b * T + (size_t)ci * 64) * 512 + h * 128 + dv0 + fr;
#pragma unroll
        for (int it = 0; it < 4; ++it)
#pragma unroll
            for (int jj = 0; jj < 4; ++jj) ob[(size_t)(16 * it + 4 * fq + jj) * 512] = o[it][jj];
    }
    float* so = Sout + (size_t)(b * 4 + h) * 128 * 128 + dv0 + fr;
#pragma unroll
    for (int kt = 0; kt < 8; ++kt)
#pragma unroll
        for (int jj = 0; jj < 4; ++jj) so[(16 * kt + 4 * fq + jj) * 128] = S[kt][jj];
}

__device__ __forceinline__ void phase_gnorm(const float* OBUF, const bf16_t* P, const float* gdn, bf16_t* MIX, int gw, int ngw, int lane) {
    const int d = (8 * lane) & 127;
    const f32x4 g0 = *(const f32x4*)(gdn + d), g1 = *(const f32x4*)(gdn + d + 4);
    for (int m = gw; m < MP; m += ngw) {
        const f32x4 a = *(const f32x4*)(OBUF + (size_t)m * 512 + 8 * lane), c = *(const f32x4*)(OBUF + (size_t)m * 512 + 8 * lane + 4);
        float ss = (a.x * a.x + a.y * a.y) + (a.z * a.z + a.w * a.w) + (c.x * c.x + c.y * c.y) + (c.z * c.z + c.w * c.w);
        ss = sum16(ss);
        const float rn = rsqrtf(ss * (1.f / 128.f) + EPS);
        float z[8]; unpack8(*(const u32x4*)(P + (size_t)m * NINP + PC_Z + 8 * lane), z);
        u32x4 o; o.x = pk2(a.x * rn * g0.x * silu_f(z[0]), a.y * rn * g0.y * silu_f(z[1])); o.y = pk2(a.z * rn * g0.z * silu_f(z[2]), a.w * rn * g0.w * silu_f(z[3]));
        o.z = pk2(c.x * rn * g1.x * silu_f(z[4]), c.y * rn * g1.y * silu_f(z[5])); o.w = pk2(c.z * rn * g1.z * silu_f(z[6]), c.w * rn * g1.w * silu_f(z[7]));
        *(u32x4*)(MIX + (size_t)m * D + 8 * lane) = o;
    }
}

__device__ __forceinline__ void phase_convgate(const bf16_t* UP, const float* cwf  , const float* cbf  , const float* stf  , bf16_t* ACT,
                                               float* outp  , float* outs  , int gtid, int ngt) {
    for (int idx = gtid; idx < MV * 352; idx += ngt) {
        const int m = idx / 352, c = (idx % 352) * 8;
        float a[8], g[8];
#pragma unroll
        for (int half = 0; half < 2; ++half) {
            const int cc = c + half * DFF;
            float r0[8], r1[8], r2[8];
            unpack8(*(const u32x4*)(UP + (size_t)m * NUP + cc), r2);
            if (m < MP) { const int t = m & (T - 1);
                if (t >= 1) unpack8(*(const u32x4*)(UP + (size_t)(m - 1) * NUP + cc), r1); else {
#pragma unroll
                    for (int e = 0; e < 8; ++e) r1[e] = 0.f; }
                if (t >= 2) unpack8(*(const u32x4*)(UP + (size_t)(m - 2) * NUP + cc), r0); else {
#pragma unroll
                    for (int e = 0; e < 8; ++e) r0[e] = 0.f; }
                if (t >= T - 2) { float* o = outp + ((size_t)(m >> 11) * 2 + (t - (T - 2))) * NUP + cc; *(f32x4*)o = (f32x4){r2[0], r2[1], r2[2], r2[3]}; *(f32x4*)(o + 4) = (f32x4){r2[4], r2[5], r2[6], r2[7]}; }
            } else { const int bs = m - MP; const float* s = stf + (size_t)bs * 2 * NUP + cc;
                const f32x4 a0 = *(const f32x4*)s, a1 = *(const f32x4*)(s + 4), b0 = *(const f32x4*)(s + NUP), b1 = *(const f32x4*)(s + NUP + 4);
                r0[0] = a0.x; r0[1] = a0.y; r0[2] = a0.z; r0[3] = a0.w; r0[4] = a1.x; r0[5] = a1.y; r0[6] = a1.z; r0[7] = a1.w;
                r1[0] = b0.x; r1[1] = b0.y; r1[2] = b0.z; r1[3] = b0.w; r1[4] = b1.x; r1[5] = b1.y; r1[6] = b1.z; r1[7] = b1.w;
                float* o = outs + (size_t)bs * 2 * NUP + cc; *(f32x4*)o = b0; *(f32x4*)(o + 4) = b1;
                *(f32x4*)(o + NUP) = (f32x4){r2[0], r2[1], r2[2], r2[3]}; *(f32x4*)(o + NUP + 4) = (f32x4){r2[4], r2[5], r2[6], r2[7]}; }
            const f32x4 w00 = *(const f32x4*)(cwf + cc), w01 = *(const f32x4*)(cwf + cc + 4), w10 = *(const f32x4*)(cwf + NUP + cc), w11 = *(const f32x4*)(cwf + NUP + cc + 4),
                        w20 = *(const f32x4*)(cwf + 2 * NUP + cc), w21 = *(const f32x4*)(cwf + 2 * NUP + cc + 4), bb0 = *(const f32x4*)(cbf + cc), bb1 = *(const f32x4*)(cbf + cc + 4);
            const float w0[8] = {w00.x, w00.y, w00.z, w00.w, w01.x, w01.y, w01.z, w01.w}, w1[8] = {w10.x, w10.y, w10.z, w10.w, w11.x, w11.y, w11.z, w11.w},
                        w2[8] = {w20.x, w20.y, w20.z, w20.w, w21.x, w21.y, w21.z, w21.w}, bb[8] = {bb0.x, bb0.y, bb0.z, bb0.w, bb1.x, bb1.y, bb1.z, bb1.w};
#pragma unroll
            for (int e = 0; e < 8; ++e) { const float v = w0[e] * r0[e] + w1[e] * r1[e] + w2[e] * r2[e] + bb[e]; if (half == 0) a[e] = v; else g[e] = v; }
        }
        float o[8];
#pragma unroll
        for (int e = 0; e < 8; ++e) o[e] = silu_f(a[e]) * g[e];
        *(u32x4*)(ACT + (size_t)m * DFF + c) = pack8(o);
    }
}

struct Args { const float* in[25]; float* out; unsigned char* ws; int ph_lo, ph_hi; };
constexpr int N_PHASES = 2 + 10 * DEPTH + 1;

__global__ void __launch_bounds__(NTHR, 2) fwd_kernel(Args args) {
    extern __shared__ __attribute__((aligned(16))) unsigned char lds[];
    cg::grid_group grid = cg::this_grid();
    const int G = gridDim.x, bx = blockIdx.x, ngw = G * NWAVES;
#define TIDS() int tid = threadIdx.x; asm volatile("" : "+v"(tid)); const int lane = tid & 63, wave = __builtin_amdgcn_readfirstlane(tid >> 6), gw = bx * NWAVES + wave; (void)lane; (void)wave; (void)gw
    unsigned char* ws = args.ws;
    const int lo = args.ph_lo, hi = args.ph_hi;
#ifndef PMASK
#define PMASK 0xFFFF
#endif
#define RUN(k) (lo <= (k) && (k) < hi)
#define EN(b) ((PMASK >> (b)) & 1)
#define SEAM(k) do { if (RUN(k) && RUN((k) + 1)) grid.sync(); } while (0)
    float* MOD = (float*)(ws + WS_MOD); float* XR = (float*)(ws + WS_XR); bf16_t* AB = (bf16_t*)(ws + WS_AB);
    bf16_t* PB = (bf16_t*)(ws + WS_BIG); float* OBUF = (float*)(ws + WS_OBUF); bf16_t* ACT = (bf16_t*)(ws + WS_ACT);
    PG8_LAS unsigned char* glds = (PG8_LAS unsigned char*)lds;

    if (EN(10) && RUN(0)) { TIDS(); phase_convert(lds, ws, args.in[10], args.in[18], args.in[20], args.in[23], args.in[7], args.in[5], args.in[6], gw, ngw, wave, lane); }
    SEAM(0);
    if (EN(11) && RUN(1)) { pg8::Gemm g{(const bf16_t*)(ws + WS_CACT), (const bf16_t*)(ws + WS_WMODT), 256, MODLD, D}; pg8::StaticOrder S; S.init(256, MODLD, G, bx);
        EpiMod E{MOD, args.in[8]}; pg8::gemm_phase<EpiMod, pg8::StaticOrder>(glds, g, S, E, nullptr); }
    SEAM(1);
#pragma unroll 1
    for (int l = 0; l < DEPTH; ++l) {
        const int pb = 2 + 10 * l;
        const unsigned char* wl = ws + WS_W + l * WL_STRIDE;
        const float* modl = MOD + l * NMOD;
        if (EN(0) && RUN(pb + 0)) { TIDS();
            if (l == 0) phase_ln(args.in[0], args.in[1], args.in[9], modl + 0 * D, modl + 1 * D, AB, XR, gw, ngw, lane);
            else phase_ln(XR, XR + (size_t)MP * D, args.in[9] + l * D, modl + 0 * D, modl + 1 * D, AB, nullptr, gw, ngw, lane);
        }
        SEAM(pb + 0);
        if (EN(1) && RUN(pb + 1)) { pg8::Gemm g{AB, (const bf16_t*)(wl + WL_IN), MPAD, NINP, D}; pg8::StaticOrder S; S.init(MPAD, NINP, G, bx);
            EpiBf E{PB, NINP}; pg8::gemm_phase<EpiBf, pg8::StaticOrder>(glds, g, S, E, nullptr); }
        SEAM(pb + 1);
        if (EN(2) && RUN(pb + 2)) { TIDS();
            const float* cw = args.in[11] + (size_t)l * 4 * QKVD;
            for (int it = bx; it < 2048; it += G) {
                if (it < 1024) { const int h = it & 3, ci = (it >> 2) & 31, b = it >> 7;
                    prep_item(lds, PB, cw, args.in[12][l * 4 + h], args.in[13][l * 4 + h], ws + WS_ACT + (size_t)it * DR_STRIDE,
                              ci == 31 ? args.out + O_QP + ((size_t)l * NB + b) * 3 * QKVD : nullptr, b, ci, h, tid); }
                else if (it < 1536) { const int j = it - 1024, h = j & 3, n = (j >> 2) & 15, b = j >> 6;
                    sgu_item(lds, PB, args.in[16] + ((size_t)l * 4 + h) * 128 * 128, args.in[17] + (l * 4 + h) * 128, args.in[15] + (l * 4 + h) * 128, AB, b, n, h, tid); }
                else { const int j = it - 1536, h = j & 3, b = j >> 2;
                    sample_item(lds, PB, cw, args.in[12][l * 4 + h], args.in[13][l * 4 + h], args.in[3] + ((size_t)l * SB + b) * 3 * QKVD,
                                args.in[2] + (((size_t)l * SB + b) * 4 + h) * 128 * 128, args.out + O_DS + (((size_t)l * SB + b) * 4 + h) * 128 * 128,
                                args.out + O_QS + ((size_t)l * SB + b) * 3 * QKVD, args.out + O_SV + (((size_t)l * SB + b) * 4 + h) * 128,
                                args.in[14] + l * 128, args.in[15] + (l * 4 + h) * 128, args.in[16][((size_t)l * 4 + h) * 128 * 128], args.in[17][(l * 4 + h) * 128], AB, b, h, tid); }
            }
        }
        SEAM(pb + 2);
        if (EN(3) && RUN(pb + 3)) { TIDS(); if (wave == 0) for (int it = bx; it < 256; it += G) scan_item(ws + WS_ACT, OBUF, args.out + O_DP + (size_t)l * NB * 4 * 128 * 128, it, lane); }
        SEAM(pb + 3);
        if (EN(4) && RUN(pb + 4)) { TIDS(); phase_gnorm(OBUF, PB, args.in[14] + l * 128, AB, gw, ngw, lane); }
        SEAM(pb + 4);
        if (EN(5) && RUN(pb + 5)) { pg8::Gemm g{AB, (const bf16_t*)(wl + WL_OUT), MPAD, D, D}; pg8::StaticOrder S; S.init(MPAD, D, G, bx);
            EpiRes E{XR, modl + 2 * D}; pg8::gemm_phase<EpiRes, pg8::StaticOrder>(glds, g, S, E, nullptr); }
        SEAM(pb + 5);
        if (EN(6) && RUN(pb + 6)) { TIDS(); phase_ln(XR, XR + (size_t)MP * D, args.in[19] + l * D, modl + 3 * D, modl + 4 * D, AB, nullptr, gw, ngw, lane); }
        SEAM(pb + 6);
        if (EN(7) && RUN(pb + 7)) { pg8::Gemm g{AB, (const bf16_t*)(wl + WL_UP), MPAD, NUP, D}; pg8::StaticOrder S; S.init(MPAD, NUP, G, bx);
            EpiBf E{PB, NUP}; pg8::gemm_phase<EpiBf, pg8::StaticOrder>(glds, g, S, E, nullptr); }
        SEAM(pb + 7);
        if (EN(8) && RUN(pb + 8)) { TIDS(); phase_convgate(PB, args.in[21] + (size_t)l * 3 * NUP, args.in[22] + (size_t)l * NUP, args.in[4] + (size_t)l * SB * 2 * NUP, ACT,
                                        args.out + O_FP + (size_t)l * NB * 2 * NUP, args.out + O_FS + (size_t)l * SB * 2 * NUP, bx * NTHR + tid, G * NTHR); }
        SEAM(pb + 8);
        if (EN(9) && RUN(pb + 9)) { pg8::Gemm g{ACT, (const bf16_t*)(wl + WL_DOWN), MPAD, D, DFF}; pg8::StaticOrder S; S.init(MPAD, D, G, bx);
            EpiRes E{XR, modl + 5 * D}; pg8::gemm_phase<EpiRes, pg8::StaticOrder>(glds, g, S, E, nullptr); }
        SEAM(pb + 9);
    }
    if (EN(12) && RUN(N_PHASES - 1)) { TIDS(); phase_final(XR, args.in[24], args.out + O_Y, gw, ngw, lane); }
#undef RUN
#undef SEAM
}

#ifndef MK_MULTI
#define MK_MULTI 0
#endif
extern "C" void kernel_launch(void* const* d_in, const int* in_sizes, int n_in, void* d_out, int out_size, void* d_ws, size_t ws_size, hipStream_t stream) {
    static int grid = 0;
    if (grid == 0) {
        if (n_in != 25 || (size_t)out_size != O_END || ws_size < WS_END) { fprintf(stderr, "kernel_launch: unexpected shapes (n_in %d out %d ws %zu need %zu)\n", n_in, out_size, ws_size, (size_t)WS_END); grid = -1; return; }
        int dev = 0, cus = 0, per_cu = 0;
        hipGetDevice(&dev); hipDeviceGetAttribute(&cus, hipDeviceAttributeMultiprocessorCount, dev);
        if (hipFuncSetAttribute((const void*)fwd_kernel, hipFuncAttributeMaxDynamicSharedMemorySize, LDS_BYTES) != hipSuccess) { fprintf(stderr, "kernel_launch: hipFuncSetAttribute failed\n"); grid = -1; return; }
        if (hipOccupancyMaxActiveBlocksPerMultiprocessor(&per_cu, (const void*)fwd_kernel, NTHR, LDS_BYTES) != hipSuccess || per_cu < 1) { fprintf(stderr, "kernel_launch: occupancy query says %d\n", per_cu); per_cu = 1; }
        (void)hipGetLastError();
        grid = cus;
    }
    if (grid < 0) return;
    Args a{};
    for (int i = 0; i < 25; ++i) a.in[i] = (const float*)d_in[i];
    a.out = (float*)d_out; a.ws = (unsigned char*)d_ws;
#if MK_MULTI
    for (int p = 0; p < N_PHASES; ++p) { a.ph_lo = p; a.ph_hi = p + 1; hipLaunchKernelGGL(fwd_kernel, dim3(grid), dim3(NTHR), LDS_BYTES, stream, a); }
#else
    a.ph_lo = 0; a.ph_hi = N_PHASES;
    void* kargs[] = {&a};
    hipError_t e = hipLaunchCooperativeKernel((const void*)fwd_kernel, dim3(grid), dim3(NTHR), kargs, LDS_BYTES, stream);
    if (e != hipSuccess) fprintf(stderr, "kernel_launch: cooperative launch failed: %s\n", hipGetErrorString(e));
#endif
}
```

```cpp
#include <hip/hip_runtime.h>
#include <hip/hip_cooperative_groups.h>
#include <cstdio>
namespace cg = cooperative_groups;
namespace pg8 {
#define PG8_LAS __attribute__((address_space(3)))
typedef unsigned short bf16_t;
typedef short bf16x8 __attribute__((ext_vector_type(8)));
typedef float f32x4 __attribute__((ext_vector_type(4)));
typedef unsigned u32x4 __attribute__((ext_vector_type(4)));
constexpr int BM = 256, BK = 64, HALF = 128, HTB = HALF * BK * 2  , STAGE_BYTES = 8 * HTB, NXCD = 8, WGM = 8;

__host__ __device__ __forceinline__ int lds_byte(int r, int c) { const int st = (r >> 4) * 2 + (c >> 5), rr = r & 15, cc = c & 31, ob = rr * 64 + cc * 2; return st * 1024 + (ob ^ (((ob >> 9) & 1) << 5)); }
__host__ __device__ __forceinline__ void stage_rc(int b, int& R, int& C) { const int st = b / 1024, sb = b % 1024, swz = sb ^ (((sb >> 9) & 1) << 5); R = (st >> 1) * 16 + swz / 64; C = (st & 1) * 32 + (swz % 64) / 2; }
__host__ __device__ __forceinline__ int perm32(int rho) { const int n = rho >> 4, i = rho & 15; return 8 * (i >> 2) + 4 * n + (i & 3); }

struct Unit { int pm, pn, koff; };
struct Gemm { const bf16_t* A; const bf16_t* Bt; int M, N, K, ld; };

struct StaticOrder {
    int nM, nN, nwg, G, c;
    __host__ __device__ void init(int M, int N, int G_, int c_) { nM = M / BM; nN = N / BM; nwg = nM * nN; G = G_; c = c_; }
    __host__ __device__ bool next(int i, Unit& u) const {
        const long L = (long)i * G + c; if (L >= nwg) return false;
        int wgid = (int)L; { const int q = nwg / NXCD, r = nwg % NXCD, xcd = wgid % NXCD, off = wgid / NXCD; wgid = (xcd < r ? xcd * (q + 1) : r * (q + 1) + (xcd - r) * q) + off; }
        const int nig = WGM * nN, gid = wgid / nig, fm = gid * WGM, gsz = (nM - fm) < WGM ? (nM - fm) : WGM;
        u.pm = fm + ((wgid % nig) % gsz); u.pn = (wgid % nig) / gsz; u.koff = 0; return true;
    }
    __device__ __forceinline__ void a_ready(const Unit&) const {}
    __device__ __forceinline__ void done(const Unit&) const {}
};
struct SplitOrder {
    int nN, nwg, G, c, pm, klen;
    __host__ __device__ void init(int N, int nsplit, int klen_, int pm_, int G_, int c_) { nN = N / BM; nwg = nN * nsplit; G = G_; c = c_; pm = pm_; klen = klen_; }
    __host__ __device__ bool next(int i, Unit& u) const { const long L = (long)i * G + c; if (L >= nwg) return false; u.pm = pm; u.pn = (int)(L % nN); u.koff = (int)(L / nN) * klen; return true; }
    __device__ __forceinline__ void a_ready(const Unit&) const {}
    __device__ __forceinline__ void done(const Unit&) const {}
};
__device__ __forceinline__ unsigned cvt_pk_bf16(float lo, float hi) { unsigned r; asm volatile("v_cvt_pk_bf16_f32 %0, %1, %2" : "=v"(r) : "v"(lo), "v"(hi)); return r; }
template <class Epi, class Sched, bool STAMP = false>
__device__ __forceinline__ void gemm_phase(PG8_LAS unsigned char* lds, const Gemm g, const Sched& S, const Epi& E, unsigned long long* stamps) {
    int tid_ = threadIdx.x; asm volatile("" : "+v"(tid_)); const int tid = tid_, wid = __builtin_amdgcn_readfirstlane(tid >> 6), lane = tid & 63, wr = wid >> 2, wc = wid & 3, fr = lane & 15, fq = lane >> 4;
    const int K = g.ld, nt = g.K / BK;
    int ts_lo = 0, ts_hi = 0, nts = 0; const unsigned long long rt_entry = STAMP ? (unsigned long long)wall_clock64() : 0ull;
#define PG8_STAMP() do { if (STAMP && wid == 0 && nts < 64) { const unsigned long long _c = (unsigned long long)clock64(); \
        ts_lo = (lane == nts) ? (int)(unsigned)_c : ts_lo; ts_hi = (lane == nts) ? (int)(unsigned)(_c >> 32) : ts_hi; ++nts; } } while (0)
    PG8_STAMP();
    unsigned voffA[2], voffB[2];
#pragma unroll
    for (int i = 0; i < 2; ++i) { int R, C; stage_rc(tid * 16 + i * 8192, R, C); const int Rb = Epi::PERM ? ((R & ~31) + perm32(R & 31)) : R;
        voffA[i] = (unsigned)(R * K + C) * 2u; voffB[i] = (unsigned)(Rb * K + C) * 2u; }
    const size_t kstep = (size_t)(BK * 2);
    const size_t hstep = (size_t)HALF * K * 2;
    const size_t tstep = 2 * hstep;
    const unsigned ldsw = (unsigned)wid * 1024u;
    const int aoff = lds_byte(wr * 64 + fr, fq * 8), boff = lds_byte(wc * 32 + fr, fq * 8);
#define PG8_SA(b, h) (((b) * 2 + (h)) * HTB)
#define PG8_SB(b, h) ((4 + (b) * 2 + (h)) * HTB)
#define PG8_STAGE(bufoff, gbase, voff) do { _Pragma("unroll") for (int _i = 0; _i < 2; ++_i) \
        __builtin_amdgcn_global_load_lds((const unsigned*)((const char*)(gbase) + (voff)[_i]), (PG8_LAS unsigned*)(lds + (bufoff) + ldsw + _i * 8192), 16, 0, 0); } while (0)
#define PG8_LDA(dst, b, h) do { _Pragma("unroll") for (int m = 0; m < 4; ++m) _Pragma("unroll") for (int k = 0; k < 2; ++k) dst[m][k] = *(const PG8_LAS bf16x8*)(lds + PG8_SA(b, h) + aoff + m * 2048 + k * 1024); } while (0)
#define PG8_LDB(dst, b, h) do { _Pragma("unroll") for (int n = 0; n < 2; ++n) _Pragma("unroll") for (int k = 0; k < 2; ++k) dst[n][k] = *(const PG8_LAS bf16x8*)(lds + PG8_SB(b, h) + boff + n * 2048 + k * 1024); } while (0)
#define PG8_MMA(ai, bj, At, Bt) do { __builtin_amdgcn_s_setprio(1); _Pragma("unroll") for (int m = 0; m < 4; ++m) _Pragma("unroll") for (int n = 0; n < 2; ++n) _Pragma("unroll") for (int k = 0; k < 2; ++k) \
        acc[ai][bj][m][n] = __builtin_amdgcn_mfma_f32_16x16x32_bf16(Bt[n][k], At[m][k], acc[ai][bj][m][n], 0, 0, 0); __builtin_amdgcn_s_setprio(0); } while (0)
#define PG8_WAIT_V(n) asm volatile("s_waitcnt vmcnt(" #n ")" ::: "memory")
#define PG8_WAIT_L(n) asm volatile("s_waitcnt lgkmcnt(" #n ")" ::: "memory")
#define PG8_BAR __builtin_amdgcn_s_barrier()
#define PG8_SCHED __builtin_amdgcn_sched_barrier(0)
    Unit cur, nxt; int ui = 0;
    if (!S.next(0, cur)) return;
    f32x4 acc[2][2][4][2];
#pragma unroll
    for (int a = 0; a < 2; ++a)
#pragma unroll
        for (int b = 0; b < 2; ++b)
#pragma unroll
            for (int m = 0; m < 4; ++m)
#pragma unroll
                for (int n = 0; n < 2; ++n) acc[a][b][m][n] = (f32x4){0.f, 0.f, 0.f, 0.f};
    bf16x8 At[4][2], B0[2][2], B1[2][2];
    const char* cA = (const char*)g.A + (size_t)cur.pm * tstep + (size_t)cur.koff * 2; const char* cB = (const char*)g.Bt + (size_t)cur.pn * tstep + (size_t)cur.koff * 2;
    S.a_ready(cur);
    PG8_STAGE(PG8_SB(0, 0), cB, voffB); PG8_STAGE(PG8_SA(0, 0), cA, voffA); PG8_STAGE(PG8_SB(0, 1), cB + hstep, voffB); PG8_STAGE(PG8_SA(0, 1), cA + hstep, voffA);
    if (wr == 1) PG8_BAR;
    PG8_WAIT_V(4); PG8_BAR;
    PG8_STAGE(PG8_SB(1, 0), cB + kstep, voffB); PG8_STAGE(PG8_SA(1, 0), cA + kstep, voffA); PG8_STAGE(PG8_SB(1, 1), cB + hstep + kstep, voffB);
    PG8_WAIT_V(6); PG8_BAR;
    PG8_STAMP();
    for (;;) {
        const bool has_next = S.next(ui + 1, nxt);
        const char* nA = has_next ? (const char*)g.A + (size_t)nxt.pm * tstep + (size_t)nxt.koff * 2 : cA; const char* nB = has_next ? (const char*)g.Bt + (size_t)nxt.pn * tstep + (size_t)nxt.koff * 2 : cB;
        for (int t = 0; t < nt; t += 2) {
            const bool last = (t == nt - 2);
            const char* a1 = cA + (size_t)(t + 1) * kstep;
            const char* a2 = last ? nA : cA + (size_t)(t + 2) * kstep; const char* b2 = last ? nB : cB + (size_t)(t + 2) * kstep;
            const char* a3 = a2 + kstep; const char* b3 = b2 + kstep;
            if (last && has_next) S.a_ready(nxt);
            PG8_LDB(B0, 0, 0); PG8_SCHED; PG8_LDA(At, 0, 0); PG8_STAGE(PG8_SA(1, 1), a1 + hstep, voffA);
            PG8_WAIT_L(8); PG8_BAR; PG8_WAIT_L(0); PG8_MMA(0, 0, At, B0); PG8_BAR; PG8_SCHED;
            PG8_LDB(B1, 0, 1); PG8_STAGE(PG8_SB(0, 0), b2, voffB);
            PG8_BAR; PG8_WAIT_L(0); PG8_MMA(0, 1, At, B1); PG8_BAR;
            PG8_LDA(At, 0, 1); PG8_STAGE(PG8_SA(0, 0), a2, voffA);
            PG8_BAR; PG8_WAIT_L(0); PG8_MMA(1, 0, At, B0); PG8_BAR; PG8_SCHED;
            PG8_STAGE(PG8_SB(0, 1), b2 + hstep, voffB);
            PG8_WAIT_V(6); PG8_BAR; PG8_MMA(1, 1, At, B1); PG8_BAR;
            PG8_LDB(B0, 1, 0); PG8_SCHED; PG8_LDA(At, 1, 0); PG8_STAGE(PG8_SA(0, 1), a2 + hstep, voffA);
            PG8_WAIT_L(8); PG8_BAR; PG8_WAIT_L(0); PG8_MMA(0, 0, At, B0); PG8_BAR; PG8_SCHED;
            PG8_LDB(B1, 1, 1); PG8_STAGE(PG8_SB(1, 0), b3, voffB);
            PG8_BAR; PG8_WAIT_L(0); PG8_MMA(0, 1, At, B1); PG8_BAR;
            PG8_LDA(At, 1, 1); PG8_STAGE(PG8_SA(1, 0), a3, voffA);
            PG8_BAR; PG8_WAIT_L(0); PG8_MMA(1, 0, At, B0); PG8_BAR; PG8_SCHED;
            PG8_STAGE(PG8_SB(1, 1), b3 + hstep, voffB);
            PG8_WAIT_V(6); PG8_BAR; PG8_MMA(1, 1, At, B1); PG8_BAR;
        }
        PG8_STAMP();
        if constexpr (!Epi::AFTER_DRAIN) { E(acc, cur, wr, wc, fr, fq); S.done(cur); }
        PG8_STAMP();
        if (!has_next) break;
#pragma unroll
        for (int a = 0; a < 2; ++a)
#pragma unroll
            for (int b = 0; b < 2; ++b)
#pragma unroll
                for (int m = 0; m < 4; ++m)
#pragma unroll
                    for (int n = 0; n < 2; ++n) acc[a][b][m][n] = (f32x4){0.f, 0.f, 0.f, 0.f};
        cur = nxt; cA = nA; cB = nB; ++ui;
    }
    PG8_WAIT_V(0);
    if (wr == 0) PG8_BAR;
    PG8_BAR;
    if constexpr (Epi::AFTER_DRAIN) { E.fused(acc, cur, wr, wc, fr, fq, lds, wid, lane); S.done(cur); }
    PG8_STAMP();
    if (STAMP && wid == 0) { stamps[lane] = lane < nts ? (((unsigned long long)(unsigned)ts_hi << 32) | (unsigned)ts_lo) : 0ull;
        if (lane == 62) stamps[62] = rt_entry; if (lane == 63) stamps[63] = (unsigned long long)wall_clock64(); }
#undef PG8_STAMP
#undef PG8_SA
#undef PG8_SB
#undef PG8_STAGE
#undef PG8_LDA
#undef PG8_LDB
#undef PG8_MMA
#undef PG8_WAIT_V
#undef PG8_WAIT_L
#undef PG8_BAR
#undef PG8_SCHED
}
}

using pg8::bf16_t; using pg8::bf16x8; using pg8::f32x4; using pg8::u32x4;
typedef unsigned u32x2 __attribute__((ext_vector_type(2)));
#define LDS_WAIT() asm volatile("s_waitcnt lgkmcnt(0)" ::: "memory")
#define LBAR() do { asm volatile("s_waitcnt lgkmcnt(0)" ::: "memory"); __builtin_amdgcn_s_barrier(); asm volatile("" ::: "memory"); } while (0)
#define MFMA16(a, b, c) __builtin_amdgcn_mfma_f32_16x16x32_bf16((a), (b), (c), 0, 0, 0)

constexpr int D = 1024, NB = 8, T = 2048, DEPTH = 4, SB = 128;
constexpr int MP = NB * T;
constexpr int MV = MP + SB;
constexpr int MPAD = 16640;
constexpr int QKVD = 1536, NIN = 3080, NINP = 3328, DFF = 2816, NUP = 5632, NMOD = 6144, MODLD = DEPTH * NMOD;
constexpr int PC_Z = 1536, PC_U = 2048, PC_VB = 2560, PC_BETA = 3072, PC_ALPHA = 3076;
constexpr float EPS = 1e-6f;
constexpr int NWAVES = 8, NTHR = 512;
constexpr int LDS_BYTES = 160 * 1024;

constexpr size_t MiB = 1u << 20;
constexpr size_t WS_W = 1 * MiB;
constexpr size_t WL_IN = 0, WL_OUT = (size_t)NINP * D * 2, WL_UP = WL_OUT + (size_t)D * D * 2, WL_DOWN = WL_UP + (size_t)NUP * D * 2, WL_STRIDE = WL_DOWN + (size_t)D * DFF * 2;
static_assert(WL_STRIDE == 25 * MiB, "weight stride");
constexpr size_t WS_MOD = WS_W + 4 * WL_STRIDE;
constexpr size_t WS_XR = WS_MOD + 13 * MiB;
constexpr size_t WS_AB = WS_XR + 65 * MiB;
constexpr size_t WS_BIG = WS_AB + 33 * MiB;
constexpr size_t WS_OBUF = WS_BIG + 106 * MiB;
constexpr size_t WS_RAW = WS_BIG + 140 * MiB;
static_assert((size_t)(MP / 64) * 4 * NUP * 4 <= 39 * MiB, "raw");
constexpr size_t WS_ACT = WS_BIG + 179 * MiB;
constexpr size_t WS_WMODT = WS_ACT;
constexpr size_t WS_CACT = WS_ACT + 48 * MiB;
constexpr size_t WS_PS = WS_ACT + 90 * MiB;
constexpr size_t WS_UPS = WS_BIG + 163 * MiB;
constexpr size_t WS_UPS_OLD = WS_PS + 7 * MiB;
constexpr size_t WS_RP = WS_UPS_OLD + 12 * MiB;
constexpr size_t WS_BA = WS_RP + 6 * MiB;
constexpr size_t WS_END = WS_BA + 1 * MiB;
constexpr int NIN_G = 3072;
static_assert((size_t)4 * SB * NIN_G * 4 <= 7 * MiB && (size_t)4 * SB * NUP * 4 <= 12 * MiB && (size_t)11 * SB * D * 4 <= 6 * MiB && (size_t)MV * 8 * 4 <= 1 * MiB, "ws map 3");
static_assert((size_t)136 * MODLD * 4 <= 13 * MiB && (size_t)MPAD * D * 4 <= 65 * MiB && (size_t)MPAD * D * 2 <= 33 * MiB, "ws map");
static_assert((size_t)MPAD * NINP * 2 <= 106 * MiB && (size_t)MPAD * NUP * 2 <= 179 * MiB && (size_t)MPAD * DFF * 2 <= 90 * MiB, "ws map 2");
constexpr int DR_NW = 0, DR_QG = 17408, DR_QK = 34816, DR_KDT = 44032, DR_UT = 62464, DR_EG = 80896, DR_STRIDE = 81152;
static_assert((size_t)1024 * DR_STRIDE <= 90 * MiB, "dr");

constexpr size_t O_Y = 0, O_DP = 16908288, O_DS = 19005440, O_QP = 52559872, O_QS = 52707328, O_FP = 55066624, O_FS = 55427072, O_SV = 61194240, O_END = 61456384;

__device__ __forceinline__ float bf2f(unsigned short b) { return __uint_as_float(((unsigned)b) << 16); }
__device__ __forceinline__ unsigned f2bf(float f) { return (unsigned)__builtin_bit_cast(unsigned short, (__bf16)f); }
typedef __bf16 bf16v2_t __attribute__((ext_vector_type(2)));
__device__ __forceinline__ unsigned pk2(float lo, float hi) { bf16v2_t v; v.x = (__bf16)lo; v.y = (__bf16)hi; return __builtin_bit_cast(unsigned, v); }
__device__ __forceinline__ float lo_f(unsigned w) { return __uint_as_float(w << 16); }
__device__ __forceinline__ float hi_f(unsigned w) { return __uint_as_float(w & 0xffff0000u); }
__device__ __forceinline__ float silu_f(float x) { return x * __builtin_amdgcn_rcpf(1.f + __expf(-x)); }
__device__ __forceinline__ float gelu_f(float x) { const float y = 0.7978845608028654f * (x + 0.044715f * x * x * x); const float th = 1.f - 2.f * __builtin_amdgcn_rcpf(__expf(2.f * y) + 1.f); return 0.5f * x * (1.f + th); }
__device__ __forceinline__ float softplus_f(float x) { return x > 20.f ? x : log1pf(__expf(x)); }
__device__ __forceinline__ float wave_sum(float v) {
#pragma unroll
    for (int o = 1; o < 64; o <<= 1) v += __shfl_xor(v, o);
    return v;
}
__device__ __forceinline__ float sum16(float v) { v += __shfl_xor(v, 1); v += __shfl_xor(v, 2); v += __shfl_xor(v, 4); v += __shfl_xor(v, 8); return v; }
__device__ __forceinline__ void unpack8(const u32x4 v, float (&x)[8]) { x[0] = lo_f(v.x); x[1] = hi_f(v.x); x[2] = lo_f(v.y); x[3] = hi_f(v.y); x[4] = lo_f(v.z); x[5] = hi_f(v.z); x[6] = lo_f(v.w); x[7] = hi_f(v.w); }
__device__ __forceinline__ u32x4 pack8(const float (&x)[8]) { u32x4 o; o.x = pk2(x[0], x[1]); o.y = pk2(x[2], x[3]); o.z = pk2(x[4], x[5]); o.w = pk2(x[6], x[7]); return o; }
__device__ __forceinline__ int mod_row(int m) { return m < MP ? (m >> 11) : (8 + m - MP); }

struct EpiMod {
    static constexpr bool PERM = false, AFTER_DRAIN = false;
    float* C; const float* bias;
    __device__ __forceinline__ void operator()(const f32x4 (&acc)[2][2][4][2], const pg8::Unit& u, int wr, int wc, int fr, int fq) const {
        const int row0 = u.pm * 256 + wr * 64 + fr, col0 = u.pn * 256 + wc * 32 + 4 * fq;
#pragma unroll
        for (int ai = 0; ai < 2; ++ai)
#pragma unroll
            for (int m = 0; m < 4; ++m) { const int row = row0 + ai * 128 + m * 16;
                if (row < 136) {
#pragma unroll
                    for (int bj = 0; bj < 2; ++bj)
#pragma unroll
                        for (int n = 0; n < 2; ++n) { const int col = col0 + bj * 128 + n * 16; *(f32x4*)(C + (size_t)row * MODLD + col) = acc[ai][bj][m][n] + *(const f32x4*)(bias + col); } } }
    }
};
struct EpiBf {
    static constexpr bool PERM = true, AFTER_DRAIN = false;
    bf16_t* O; int ldc;
    __device__ __forceinline__ void operator()(const f32x4 (&acc)[2][2][4][2], const pg8::Unit& u, int wr, int wc, int fr, int fq) const {
        const int row0 = u.pm * 256 + wr * 64 + fr, col0 = u.pn * 256 + wc * 32 + 8 * fq;
#pragma unroll
        for (int ai = 0; ai < 2; ++ai)
#pragma unroll
            for (int m = 0; m < 4; ++m) { bf16_t* rowp = O + (size_t)(row0 + ai * 128 + m * 16) * ldc + col0;
#pragma unroll
                for (int bj = 0; bj < 2; ++bj) { const f32x4 v0 = acc[ai][bj][m][0], v1 = acc[ai][bj][m][1];
                    u32x4 w; w.x = pg8::cvt_pk_bf16(v0[0], v0[1]); w.y = pg8::cvt_pk_bf16(v0[2], v0[3]); w.z = pg8::cvt_pk_bf16(v1[0], v1[1]); w.w = pg8::cvt_pk_bf16(v1[2], v1[3]);
                    *(u32x4*)(rowp + bj * 128) = w; } }
    }
};
struct EpiRes {
    static constexpr bool PERM = false, AFTER_DRAIN = false;
    float* X; const float* gate; int gs;
    __device__ __forceinline__ void operator()(const f32x4 (&acc)[2][2][4][2], const pg8::Unit& u, int wr, int wc, int fr, int fq) const {
        const int row0 = u.pm * 256 + wr * 64 + fr, col0 = u.pn * 256 + wc * 32 + 4 * fq;
        const float* gp = gate + (size_t)mod_row(u.pm * 256) * gs;
        f32x4 g[2][2];
#pragma unroll
        for (int bj = 0; bj < 2; ++bj)
#pragma unroll
            for (int n = 0; n < 2; ++n) g[bj][n] = *(const f32x4*)(gp + col0 + bj * 128 + n * 16);
        f32x4 xn[2][2];
        { float* xp = X + (size_t)row0 * D;
#pragma unroll
          for (int bj = 0; bj < 2; ++bj)
#pragma unroll
              for (int n = 0; n < 2; ++n) xn[bj][n] = *(const f32x4*)(xp + col0 + bj * 128 + n * 16); }
#pragma unroll
        for (int gi = 0; gi < 8; ++gi) { const int ai = gi >> 2, m = gi & 3; const int row = row0 + ai * 128 + m * 16;
            f32x4 xc[2][2];
#pragma unroll
            for (int bj = 0; bj < 2; ++bj)
#pragma unroll
                for (int n = 0; n < 2; ++n) xc[bj][n] = xn[bj][n];
            if (gi + 1 < 8) { const int rown = row0 + ((gi + 1) >> 2) * 128 + ((gi + 1) & 3) * 16; const float* xq = X + (size_t)rown * D;
#pragma unroll
                for (int bj = 0; bj < 2; ++bj)
#pragma unroll
                    for (int n = 0; n < 2; ++n) xn[bj][n] = *(const f32x4*)(xq + col0 + bj * 128 + n * 16); }
            float* xp = X + (size_t)row * D;
#pragma unroll
            for (int bj = 0; bj < 2; ++bj)
#pragma unroll
                for (int n = 0; n < 2; ++n) *(f32x4*)(xp + col0 + bj * 128 + n * 16) = xc[bj][n] + g[bj][n] * acc[ai][bj][m][n]; }
    }
};

struct EpiPart {
    static constexpr bool PERM = false, AFTER_DRAIN = false;
    float* C; int N, klen;
    __device__ __forceinline__ void operator()(const f32x4 (&acc)[2][2][4][2], const pg8::Unit& u, int wr, int wc, int fr, int fq) const {
        const int lrow0 = wr * 64 + fr, col0 = u.pn * 256 + wc * 32 + 4 * fq;
        float* base = C + (size_t)(u.koff / klen) * SB * N;
#pragma unroll
        for (int m = 0; m < 4; ++m) { float* rp = base + (size_t)(lrow0 + m * 16) * N + col0;
#pragma unroll
            for (int bj = 0; bj < 2; ++bj)
#pragma unroll
                for (int n = 0; n < 2; ++n) *(f32x4*)(rp + bj * 128 + n * 16) = acc[0][bj][m][n]; }
    }
};

#define DPP_F(oldv, srcv, ctrl) __int_as_float(__builtin_amdgcn_update_dpp(__float_as_int(oldv), __float_as_int(srcv), (ctrl), 0xF, 0xF, false))
struct EpiUpCG {
    static constexpr bool PERM = true, AFTER_DRAIN = false;
    bf16_t* ACTp; float* RAW; const float* cwf; const float* cbf;
    __device__ __forceinline__ void operator()(const f32x4 (&acc)[2][2][4][2], const pg8::Unit& u, int wr, int wc, int fr, int fq) const {
        const int cc0 = wc * 32 + 8 * fq, ca0 = 128 * u.pn + cc0;
        if (u.pm == MP / 256) {
            float* rp = RAW + (WS_UPS - WS_RAW) / 4 + (size_t)(wr * 64 + fr) * NUP + 256 * u.pn + cc0;
#pragma unroll
            for (int m = 0; m < 4; ++m) {
#pragma unroll
                for (int bj = 0; bj < 2; ++bj) { *(f32x4*)(rp + (size_t)m * 16 * NUP + bj * 128) = acc[0][bj][m][0]; *(f32x4*)(rp + (size_t)m * 16 * NUP + bj * 128 + 4) = acc[0][bj][m][1]; } }
            return; }
#pragma unroll
        for (int n = 0; n < 2; ++n) {
            const int ca = ca0 + 4 * n;
            const f32x4 w0a = *(const f32x4*)(cwf + ca), w1a = *(const f32x4*)(cwf + NUP + ca), w2a = *(const f32x4*)(cwf + 2 * NUP + ca), ba = *(const f32x4*)(cbf + ca);
            const f32x4 w0g = *(const f32x4*)(cwf + DFF + ca), w1g = *(const f32x4*)(cwf + NUP + DFF + ca), w2g = *(const f32x4*)(cwf + 2 * NUP + DFF + ca), bg = *(const f32x4*)(cbf + DFF + ca);
#pragma unroll
            for (int ai = 0; ai < 2; ++ai) {
                const int slab = u.pm * 4 + ai * 2 + wr;
                float* rawp = RAW + (size_t)slab * 4 * NUP + 256 * u.pn + cc0 + 4 * n;
#pragma unroll
                for (int m = 0; m < 4; ++m) {
                    const f32x4 xa = acc[ai][0][m][n], xg = acc[ai][1][m][n];
                    const f32x4 pa = acc[ai][0][m > 0 ? m - 1 : 0][n], pg = acc[ai][1][m > 0 ? m - 1 : 0][n];
                    float o[4];
#pragma unroll
                    for (int j = 0; j < 4; ++j) {
                        const float a1 = DPP_F(DPP_F(0.f, pa[j], 0x121), xa[j], 0x111), a2 = DPP_F(DPP_F(0.f, pa[j], 0x122), xa[j], 0x112);
                        const float g1 = DPP_F(DPP_F(0.f, pg[j], 0x121), xg[j], 0x111), g2 = DPP_F(DPP_F(0.f, pg[j], 0x122), xg[j], 0x112);
                        const float va = w0a[j] * a2 + w1a[j] * a1 + w2a[j] * xa[j] + ba[j];
                        const float vg = w0g[j] * g2 + w1g[j] * g1 + w2g[j] * xg[j] + bg[j];
                        o[j] = silu_f(va) * vg; }
                    const int row = u.pm * 256 + ai * 128 + wr * 64 + m * 16 + fr;
                    if (!(m == 0 && fr < 2)) { u32x2 w; w.x = pg8::cvt_pk_bf16(o[0], o[1]); w.y = pg8::cvt_pk_bf16(o[2], o[3]); *(u32x2*)(ACTp + (size_t)row * DFF + ca) = w; }
                    if (m == 0 && fr < 2) { *(f32x4*)(rawp + (size_t)fr * NUP) = xa; *(f32x4*)(rawp + (size_t)fr * NUP + 128) = xg; }
                    if (m == 3 && fr >= 14) { *(f32x4*)(rawp + (size_t)(fr - 12) * NUP) = xa; *(f32x4*)(rawp + (size_t)(fr - 12) * NUP + 128) = xg; }
                }
            }
        }
    }
};

__device__ __forceinline__ void tr_item(const float* W, int ldw, int K, int nblk, bf16_t* WT, float* scr, int item, int lane) {
    const int kb = item / nblk, nb = item % nblk, k0 = 64 * kb, n0 = 32 * nb;
#pragma unroll 8
    for (int i = 0; i < 32; ++i) { const int kk = 2 * i + (lane >> 5); scr[kk * 33 + (lane & 31)] = W[(size_t)(k0 + kk) * ldw + n0 + (lane & 31)]; }
    LDS_WAIT();
    const int c = lane & 7;
#pragma unroll
    for (int j = 0; j < 4; ++j) { const int n = (lane >> 3) + 8 * j; const float* s = scr + (8 * c) * 33 + n;
        u32x4 o; o.x = pk2(s[0 * 33], s[1 * 33]); o.y = pk2(s[2 * 33], s[3 * 33]); o.z = pk2(s[4 * 33], s[5 * 33]); o.w = pk2(s[6 * 33], s[7 * 33]);
        *(u32x4*)(WT + (size_t)(n0 + n) * K + k0 + 8 * c) = o; }
    LDS_WAIT();
}
constexpr int CV_PER_LAYER = 1024 + 256 + 256 + 264 + 512 + 2816 + 1408 + 3072;

__device__ __forceinline__ void phase_convert(unsigned char* lds, unsigned char* ws, const float* w_in, const float* w_out, const float* w_up, const float* w_down, const float* w_mod,
                                              const float* c_prompt, const float* c_sample, int gw, int ngw, int wave, int lane) {
    float* scr = (float*)(lds + wave * 16384);
    for (int it = gw; it < DEPTH * CV_PER_LAYER; it += ngw) {
        const int l = it / CV_PER_LAYER; int r = it % CV_PER_LAYER;
        const float* win = w_in + (size_t)l * D * NIN;
        bf16_t* wl = (bf16_t*)(ws + WS_W + l * WL_STRIDE);
        bf16_t* wint = wl;
        if (r < 1024) { tr_item(win, NIN, D, 64, wint, scr, r, lane); continue; } r -= 1024;
        if (r < 256) { tr_item(win + 2056, NIN, D, 16, wint + (size_t)PC_U * D, scr, r, lane); continue; } r -= 256;
        if (r < 256) { tr_item(win + 2568, NIN, D, 16, wint + (size_t)PC_VB * D, scr, r, lane); continue; } r -= 256;
        if (r < 264) {
            if (r < 16) { const int k = 64 * r + lane;
#pragma unroll
                for (int n = 0; n < 8; ++n) wint[(size_t)(PC_BETA + n) * D + k] = (bf16_t)f2bf(win[(size_t)k * NIN + 2048 + n]); }
            else { u32x4* z = (u32x4*)(wint + (size_t)(NIN + (r - 16)) * D); const u32x4 zero = {0u, 0u, 0u, 0u}; z[lane] = zero; z[lane + 64] = zero; }
            continue; } r -= 264;
        if (r < 512) { tr_item(w_out + (size_t)l * D * D, D, D, 32, (bf16_t*)((unsigned char*)wl + WL_OUT), scr, r, lane); continue; } r -= 512;
        if (r < 2816) {
            const int kb = r / 176, nb = r % 176, c0 = 32 * nb, hf = c0 >= DFF ? 1 : 0, cl = c0 - hf * DFF;
            const int drow = 256 * (cl >> 7) + 128 * hf + (cl & 127);
            tr_item(w_up + (size_t)l * D * NUP + c0, NUP, D, 1, (bf16_t*)((unsigned char*)wl + WL_UP) + (size_t)drow * D, scr, kb, lane); continue; } r -= 2816;
        if (r < 1408) { tr_item(w_down + (size_t)l * DFF * D, D, DFF, 32, (bf16_t*)((unsigned char*)wl + WL_DOWN), scr, r, lane); continue; } r -= 1408;
        tr_item(w_mod + (size_t)l * D * NMOD, NMOD, D, 192, (bf16_t*)(ws + WS_WMODT) + (size_t)l * NMOD * D, scr, r, lane);
    }
    bf16_t* cact = (bf16_t*)(ws + WS_CACT);
    for (int idx = gw * 64 + lane; idx < 256 * 128; idx += ngw * 64) {
        const int row = idx >> 7, c8 = (idx & 127) * 8; u32x4 o = {0u, 0u, 0u, 0u};
        if (row < 136) { const float* src = row < 8 ? c_prompt + (size_t)row * D + c8 : c_sample + (size_t)(row - 8) * D + c8;
            const f32x4 a = *(const f32x4*)src, b = *(const f32x4*)(src + 4);
            o.x = pk2(silu_f(a.x), silu_f(a.y)); o.y = pk2(silu_f(a.z), silu_f(a.w)); o.z = pk2(silu_f(b.x), silu_f(b.y)); o.w = pk2(silu_f(b.z), silu_f(b.w)); }
        *(u32x4*)(cact + (size_t)row * D + c8) = o;
    }
}

__device__ __forceinline__ void phase_ln(const float* xa, const float* xb, const float* nw, const float* sh, const float* sc, bf16_t* out, float* xr_copy,
                                         const float* part, int nsplit, const float* pgate, float* xw, const f32x4* tba, float* BA, int gw, int ngw, int lane) {
    f32x4 vnx[4];
#pragma unroll
    for (int j = 0; j < 4; ++j) vnx[j] = (f32x4){0.f, 0.f, 0.f, 0.f};
    f32x4 nwv[4], scn[4], shn[4];
#pragma unroll
    for (int j = 0; j < 4; ++j) { nwv[j] = *(const f32x4*)(nw + 4 * lane + 256 * j); scn[j] = (f32x4){0.f, 0.f, 0.f, 0.f}; shn[j] = (f32x4){0.f, 0.f, 0.f, 0.f}; }
    if (gw < MV) { const f32x4* xr0 = (const f32x4*)(gw < MP ? xa + (size_t)gw * D : xb + (size_t)(gw - MP) * D) + lane; const size_t mo = (size_t)mod_row(gw) * MODLD + 4 * lane;
#pragma unroll
        for (int j = 0; j < 4; ++j) { vnx[j] = xr0[64 * j]; scn[j] = *(const f32x4*)(sc + mo + 256 * j); shn[j] = *(const f32x4*)(sh + mo + 256 * j); } }
    for (int m = gw; m < MPAD; m += ngw) {
        u32x2* o8 = (u32x2*)(out + (size_t)m * D) + lane;
        if (m >= MV) { const u32x2 z = {0u, 0u};
#pragma unroll
            for (int j = 0; j < 4; ++j) o8[64 * j] = z;
            continue; }
        const int mr = mod_row(m);
        f32x4 v[4]; float s = 0.f;
        f32x4 scc[4], shc[4];
#pragma unroll
        for (int j = 0; j < 4; ++j) { v[j] = vnx[j]; scc[j] = scn[j]; shc[j] = shn[j]; }
        { const int mn = m + ngw;
          if (mn < MV) { const f32x4* xrn = (const f32x4*)(mn < MP ? xa + (size_t)mn * D : xb + (size_t)(mn - MP) * D) + lane; const size_t mo = (size_t)mod_row(mn) * MODLD + 4 * lane;
#pragma unroll
              for (int j = 0; j < 4; ++j) { vnx[j] = xrn[64 * j]; scn[j] = *(const f32x4*)(sc + mo + 256 * j); shn[j] = *(const f32x4*)(sh + mo + 256 * j); } } }
        if (m >= MP && nsplit > 0) {
#pragma unroll
            for (int j = 0; j < 4; ++j) { const int c = 4 * lane + 256 * j; f32x4 a = {0.f, 0.f, 0.f, 0.f};
                { f32x4 pt[11];
#pragma unroll
                  for (int ks = 0; ks < 11; ++ks) { if (ks < nsplit) pt[ks] = *(const f32x4*)(part + ((size_t)ks * SB + (m - MP)) * D + c); else pt[ks] = (f32x4){0.f, 0.f, 0.f, 0.f}; }
#pragma unroll
                  for (int ks = 0; ks < 11; ++ks) a += pt[ks]; }
                v[j] += a * *(const f32x4*)(pgate + (size_t)mr * MODLD + c);
                *(f32x4*)(xw + (size_t)m * D + c) = v[j]; } }
#pragma unroll
        for (int j = 0; j < 4; ++j) s += (v[j].x * v[j].x + v[j].y * v[j].y) + (v[j].z * v[j].z + v[j].w * v[j].w);
        s = wave_sum(s);
        const float rstd = __builtin_amdgcn_rsqf(s * (1.f / D) + EPS);
        f32x4 d0 = {0.f, 0.f, 0.f, 0.f}, d1 = {0.f, 0.f, 0.f, 0.f};
#pragma unroll
        for (int j = 0; j < 4; ++j) { const int c = 4 * lane + 256 * j;
            const f32x4 w = nwv[j], s1 = scc[j], s0 = shc[j];
            const f32x4 h = v[j] * rstd * w * (s1 + 1.f) + s0;
            u32x2 o; o.x = pk2(h.x, h.y); o.y = pk2(h.z, h.w); o8[64 * j] = o;
            if (xr_copy) *((f32x4*)(xr_copy + (size_t)m * D) + lane + 64 * j) = v[j];
            if (tba) {
#pragma unroll
                for (int e = 0; e < 4; ++e) { const float he = h[e]; d0 += tba[((j * 4 + e) * 2 + 0) * 64 + lane] * he; d1 += tba[((j * 4 + e) * 2 + 1) * 64 + lane] * he; } } }
        if (tba) {
            d0.x = wave_sum(d0.x); d0.y = wave_sum(d0.y); d0.z = wave_sum(d0.z); d0.w = wave_sum(d0.w);
            d1.x = wave_sum(d1.x); d1.y = wave_sum(d1.y); d1.z = wave_sum(d1.z); d1.w = wave_sum(d1.w);
            if (lane == 0) { *(f32x4*)(BA + (size_t)m * 8) = d0; *(f32x4*)(BA + (size_t)m * 8 + 4) = d1; } }
    }
}
__device__ __forceinline__ void fill_tba(float* T, const float* win, int tid) {
    for (int idx = tid; idx < 8192; idx += NTHR) { const int i = idx & 3, ln = (idx >> 2) & 63, half = (idx >> 8) & 1, e = (idx >> 9) & 3, j = idx >> 11;
        T[idx] = win[(size_t)(4 * ln + 256 * j + e) * NIN + 2048 + 4 * half + i]; }
    __syncthreads();
}
__device__ __forceinline__ void phase_final(const float* X, const float* fw, float* out, const float* part, int nsplit, const float* pgate, int gw, int ngw, int lane) {
    f32x4 fwv[4], vnx[4];
#pragma unroll
    for (int j = 0; j < 4; ++j) { fwv[j] = *(const f32x4*)(fw + 4 * lane + 256 * j); vnx[j] = (f32x4){0.f, 0.f, 0.f, 0.f}; }
    if (gw < MV) { const f32x4* xr0 = (const f32x4*)(X + (size_t)gw * D) + lane;
#pragma unroll
        for (int j = 0; j < 4; ++j) vnx[j] = xr0[64 * j]; }
    for (int m = gw; m < MV; m += ngw) {
        f32x4 v[4]; float s = 0.f;
#pragma unroll
        for (int j = 0; j < 4; ++j) v[j] = vnx[j];
        { const int mn = m + ngw; if (mn < MV) { const f32x4* xrn = (const f32x4*)(X + (size_t)mn * D) + lane;
#pragma unroll
            for (int j = 0; j < 4; ++j) vnx[j] = xrn[64 * j]; } }
        if (m >= MP) { const int mr = mod_row(m);
#pragma unroll
            for (int j = 0; j < 4; ++j) { const int c = 4 * lane + 256 * j; f32x4 a = {0.f, 0.f, 0.f, 0.f};
                { f32x4 pt[11];
#pragma unroll
                  for (int ks = 0; ks < 11; ++ks) { if (ks < nsplit) pt[ks] = *(const f32x4*)(part + ((size_t)ks * SB + (m - MP)) * D + c); else pt[ks] = (f32x4){0.f, 0.f, 0.f, 0.f}; }
#pragma unroll
                  for (int ks = 0; ks < 11; ++ks) a += pt[ks]; }
                v[j] += a * *(const f32x4*)(pgate + (size_t)mr * MODLD + c); } }
#pragma unroll
        for (int j = 0; j < 4; ++j) s += (v[j].x * v[j].x + v[j].y * v[j].y) + (v[j].z * v[j].z + v[j].w * v[j].w);
        s = wave_sum(s);
        const float rstd = __builtin_amdgcn_rsqf(s * (1.f / D) + EPS);
#pragma unroll
        for (int j = 0; j < 4; ++j) *((f32x4*)(out + (size_t)m * D) + lane + 64 * j) = v[j] * rstd * fwv[j];
    }
}

template <int I> struct FwdSub {
    static __device__ __forceinline__ void run(float (&sol)[64], const float* sLv, const float (&Lc)[64]) {
        float Ln[64];
#pragma unroll
        for (int q = 0; q < 16; ++q) if (I + 1 < 64 && 4 * q < I + 1) { const f32x4 t4 = *(const f32x4*)(sLv + (I + 1) * 68 + 4 * q); Ln[4 * q] = t4.x; Ln[4 * q + 1] = t4.y; Ln[4 * q + 2] = t4.z; Ln[4 * q + 3] = t4.w; }
        float a0 = sol[I], a1 = 0.f;
#pragma unroll
        for (int j = 0; j < I; ++j) { if (j & 1) a1 -= Lc[j] * sol[j]; else a0 -= Lc[j] * sol[j]; }
        sol[I] = a0 + a1;
        FwdSub<I + 1>::run(sol, sLv, Ln);
    }
};
template <> struct FwdSub<64> { static __device__ __forceinline__ void run(float (&)[64], const float*, const float (&)[64]) {} };

struct PrepIn { float braw, araw; };
__device__ __forceinline__ void prep_fetch(PrepIn& I, const bf16_t* P, const float* BA, int b, int ci, int h, int tid) {
    const size_t m0 = (size_t)b * T + (size_t)ci * 64;
    I.braw = 0.f; I.araw = 0.f;
    if (tid < 64) { I.braw = BA[(m0 + tid) * 8 + h]; I.araw = BA[(m0 + tid) * 8 + 4 + h]; }
    const int grp = tid & 15, run = (tid >> 4) & 7, tensor = tid >> 7;
    const int ch = tensor * 512 + h * 128 + grp * 8, tbase = run * 8;
    (void)ch; (void)tbase;
}
__device__ __forceinline__ void prep_item(unsigned char* lds, const bf16_t* P, const float* BA, const float* cw, float alog, float dtb, unsigned char* dr, float* qkvconv_out, int b, int ci, int h, int tid,
                                          const PrepIn& cur, PrepIn& nxt, bool has_next, int nb, int nci, int nh) {
    asm volatile("" : "+v"(tid));
    bf16_t* sKn = (bf16_t*)lds; bf16_t* sKB = (bf16_t*)(lds + 17408); bf16_t* sQ = (bf16_t*)(lds + 34816);
    float* sRhs = (float*)(lds + 52224); float* sL = (float*)(lds + 117760); float* sBeta = (float*)(lds + 135168); float* sGc = (float*)(lds + 135424);
    const int lane = tid & 63, wid = __builtin_amdgcn_readfirstlane(tid >> 6);
    const size_t m0 = (size_t)b * T + (size_t)ci * 64;
    if (tid < 64) {
        const float braw = cur.braw, araw = cur.araw;
        const float beta = __builtin_amdgcn_rcpf(1.f + __expf(-braw));
        float g = -__expf(alog) * softplus_f(araw + dtb);
#pragma unroll
        for (int off = 1; off < 64; off <<= 1) { const float v = __shfl_up(g, off); if (lane >= off) g += v; }
        sBeta[tid] = beta; sGc[tid] = g;
    }
    LBAR();
    const float gl = sGc[63];
    if (tid < 384) {
        const int grp = tid & 15, run = (tid >> 4) & 7, tensor = __builtin_amdgcn_readfirstlane(tid >> 7);
        const int ch = tensor * 512 + h * 128 + grp * 8, tbase = run * 8;
        u32x4 xr[11];
#pragma unroll
        for (int q = 0; q < 11; ++q) { const int tt = tbase - 3 + q; if (ci * 64 + tt >= 0) xr[q] = *(const u32x4*)(P + (size_t)((long)m0 + tt) * NINP + ch); else xr[q] = (u32x4){0u, 0u, 0u, 0u}; }
        f32x4 wa[4], wb[4];
#pragma unroll
        for (int j = 0; j < 4; ++j) { wa[j] = *(const f32x4*)(cw + j * QKVD + ch); wb[j] = *(const f32x4*)(cw + j * QKVD + ch + 4); }
#pragma unroll
        for (int q2 = 0; q2 < 8; ++q2) {
            const int t = tbase + q2;
            float y[8];
#pragma unroll
            for (int e = 0; e < 8; ++e) y[e] = 0.f;
#pragma unroll
            for (int j = 0; j < 4; ++j) {
                float x[8]; unpack8(xr[q2 + j], x);
                y[0] += wa[j].x * x[0]; y[1] += wa[j].y * x[1]; y[2] += wa[j].z * x[2]; y[3] += wa[j].w * x[3];
                y[4] += wb[j].x * x[4]; y[5] += wb[j].y * x[5]; y[6] += wb[j].z * x[6]; y[7] += wb[j].w * x[7];
            }
            if (qkvconv_out != nullptr && t >= 61) { float x[8]; unpack8(xr[q2 + 3], x); float* o = qkvconv_out + (size_t)(t - 61) * QKVD + ch;
                *(f32x4*)o = (f32x4){x[0], x[1], x[2], x[3]}; *(f32x4*)(o + 4) = (f32x4){x[4], x[5], x[6], x[7]}; }
            float ss = 0.f;
#pragma unroll
            for (int e = 0; e < 8; ++e) { y[e] = silu_f(y[e]); ss += y[e] * y[e]; }
            ss = sum16(ss);
            const float bt = sBeta[t], gc = sGc[t];
            if (tensor == 0) {
                const float rn = __builtin_amdgcn_rsqf(ss + EPS) * 0.08838834764831845f;
#pragma unroll
                for (int e = 0; e < 8; ++e) y[e] *= rn;
                *(u32x4*)(sQ + t * 136 + grp * 8) = pack8(y);
                const float eg = __expf(gc);
#pragma unroll
                for (int e = 0; e < 8; ++e) y[e] *= eg;
                *(u32x4*)(dr + DR_QG + (t * 136 + grp * 8) * 2) = pack8(y);
            } else if (tensor == 1) {
                const float rn = __builtin_amdgcn_rsqf(ss + EPS);
#pragma unroll
                for (int e = 0; e < 8; ++e) y[e] *= rn;
                *(u32x4*)(sKn + t * 136 + grp * 8) = pack8(y);
                const float kd = __expf(gl - gc);
                bf16_t* kdt = (bf16_t*)(dr + DR_KDT) + grp * 8 * 72 + tbase;
#pragma unroll
                for (int e = 0; e < 8; ++e) kdt[e * 72 + q2] = (bf16_t)f2bf(y[e] * kd);
#pragma unroll
                for (int e = 0; e < 8; ++e) y[e] *= bt;
                *(u32x4*)(sKB + t * 136 + grp * 8) = pack8(y);
                const float eg = __expf(gc);
                float* r = sRhs + t * 256 + 128 + grp * 8;
                *(f32x4*)r = (f32x4){y[0] * eg, y[1] * eg, y[2] * eg, y[3] * eg}; *(f32x4*)(r + 4) = (f32x4){y[4] * eg, y[5] * eg, y[6] * eg, y[7] * eg};
            } else {
                float* r = sRhs + t * 256 + grp * 8;
                *(f32x4*)r = (f32x4){y[0] * bt, y[1] * bt, y[2] * bt, y[3] * bt}; *(f32x4*)(r + 4) = (f32x4){y[4] * bt, y[5] * bt, y[6] * bt, y[7] * bt};
            }
            __builtin_amdgcn_sched_barrier(0);
        }
    }
    LBAR();
    if (has_next) prep_fetch(nxt, P, BA, nb, nci, nh, tid);
    {
        const int rt = wid & 3, isqk = wid >> 2, fr = lane & 15, fq = lane >> 4;
        const bf16_t* asrc = isqk ? sQ : sKB;
        bf16x8 a[4];
#pragma unroll
        for (int ks = 0; ks < 4; ++ks) a[ks] = *(const bf16x8*)(asrc + (16 * rt + fr) * 136 + ks * 32 + fq * 8);
        bf16_t* qkg = (bf16_t*)(dr + DR_QK);
#pragma unroll
        for (int ct = 0; ct < 4; ++ct) {
            f32x4 acc = {0.f, 0.f, 0.f, 0.f};
            if (ct <= rt) {
#pragma unroll
                for (int ks = 0; ks < 4; ++ks) { const bf16x8 bb = *(const bf16x8*)(sKn + (16 * ct + fr) * 136 + ks * 32 + fq * 8); acc = MFMA16(a[ks], bb, acc); }
            }
            const int j = 16 * ct + fr; const float gj = sGc[j];
#pragma unroll
            for (int jj = 0; jj < 4; ++jj) { const int i = 16 * rt + 4 * fq + jj; const float d = __expf(fminf(sGc[i] - gj, 0.f));
                if (!isqk) { if (ct <= rt) sL[i * 68 + j] = (j < i) ? acc[jj] * d : 0.f; }
                else { const float v = (j <= i) ? acc[jj] * d : 0.f; qkg[i * 72 + j] = (bf16_t)f2bf(v); } }
        }
    }
    LBAR();
    if (wid < 4) {
        const int col = wid * 64 + lane;
        int vz; asm volatile("v_mov_b32 %0, 0" : "=v"(vz));
        const float* sLv = sL + vz;
        float sol[64];
#pragma unroll
        for (int i = 0; i < 64; ++i) sol[i] = sRhs[i * 256 + col];
        float Lc[64];
        { const f32x4 t4 = *(const f32x4*)(sLv + 1 * 68); Lc[0] = t4.x; Lc[1] = t4.y; Lc[2] = t4.z; Lc[3] = t4.w; }
        FwdSub<1>::run(sol, sLv, Lc);
        if (wid < 2) { u32x4* dst = (u32x4*)(dr + DR_UT + col * 144);
#pragma unroll
            for (int q = 0; q < 8; ++q) { u32x4 o; o.x = pk2(sol[8 * q], sol[8 * q + 1]); o.y = pk2(sol[8 * q + 2], sol[8 * q + 3]); o.z = pk2(sol[8 * q + 4], sol[8 * q + 5]); o.w = pk2(sol[8 * q + 6], sol[8 * q + 7]); dst[q] = o; } }
        else { bf16_t* nw = (bf16_t*)(dr + DR_NW); const int k = col - 128;
#pragma unroll
            for (int i = 0; i < 64; ++i) nw[i * 136 + k] = (bf16_t)f2bf(-sol[i]); }
    }
    if (tid == 0) *(float*)(dr + DR_EG) = __expf(gl);
    LBAR();
}

__device__ __forceinline__ void sgu_item(unsigned char* lds, const bf16_t* P, const float* Wl, const float* bl, const float* nl, bf16_t* MIX, int b, int n, int h, int tid) {
    asm volatile("" : "+v"(tid));
    bf16_t* sW = (bf16_t*)lds; bf16_t* sVt = (bf16_t*)(lds + 34816);
    const int lane = tid & 63, wid = __builtin_amdgcn_readfirstlane(tid >> 6);
    const size_t m0 = (size_t)b * T + (size_t)n * 128;
    { const int i = tid >> 2, j0 = (tid & 3) * 32;
#pragma unroll
      for (int q = 0; q < 4; ++q) { const f32x4 w0 = *(const f32x4*)(Wl + i * 128 + j0 + 8 * q), w1 = *(const f32x4*)(Wl + i * 128 + j0 + 8 * q + 4);
          float x[8] = {w0.x, w0.y, w0.z, w0.w, w1.x, w1.y, w1.z, w1.w};
#pragma unroll
          for (int e = 0; e < 8; ++e) x[e] = (j0 + 8 * q + e <= i) ? x[e] : 0.f;
          *(u32x4*)(sW + i * 136 + j0 + 8 * q) = pack8(x); } }
    u32x2 uvv[8];
#pragma unroll
    for (int dt = 0; dt < 8; ++dt) uvv[dt] = *(const u32x2*)(P + (m0 + 16 * wid + (lane & 15)) * NINP + PC_U + h * 128 + 16 * dt + 4 * (lane >> 4));
    u32x4 xvv[4];
#pragma unroll
    for (int r = 0; r < 4; ++r) xvv[r] = *(const u32x4*)(P + (m0 + (tid >> 4) + 32 * r) * NINP + PC_VB + h * 128 + (tid & 15) * 8);
#pragma unroll
    for (int r = 0; r < 4; ++r) { const int j = (tid >> 4) + 32 * r, grp = tid & 15;
        const u32x4 xv = xvv[r];
        float x[8]; unpack8(xv, x); float ss = 0.f;
#pragma unroll
        for (int e = 0; e < 8; ++e) { x[e] = gelu_f(x[e]); ss += x[e] * x[e]; }
        ss = sum16(ss);
        const float rn = __builtin_amdgcn_rsqf(ss * (1.f / 128.f) + EPS);
        const f32x4 n0 = *(const f32x4*)(nl + grp * 8), n1 = *(const f32x4*)(nl + grp * 8 + 4);
        const float nn[8] = {n0.x, n0.y, n0.z, n0.w, n1.x, n1.y, n1.z, n1.w};
#pragma unroll
        for (int e = 0; e < 8; ++e) sVt[(grp * 8 + e) * 136 + j] = (bf16_t)f2bf(x[e] * rn * nn[e]); }
    LBAR();
    { const int fr = lane & 15, fq = lane >> 4;
      f32x4 acc[8];
#pragma unroll
      for (int dt = 0; dt < 8; ++dt) acc[dt] = (f32x4){0.f, 0.f, 0.f, 0.f};
      for (int ks = 0; ks <= (wid >> 1); ++ks) {
          const bf16x8 a = *(const bf16x8*)(sW + (16 * wid + fr) * 136 + 32 * ks + 8 * fq);
#pragma unroll
          for (int dt = 0; dt < 8; ++dt) { const bf16x8 bb = *(const bf16x8*)(sVt + (16 * dt + fr) * 136 + 32 * ks + 8 * fq); acc[dt] = MFMA16(bb, a, acc[dt]); } }
      const int i = 16 * wid + fr; const float bi = bl[i]; const size_t m = m0 + i;
#pragma unroll
      for (int dt = 0; dt < 8; ++dt) { const int d = 16 * dt + 4 * fq;
          const u32x2 uv = uvv[dt];
          const float u0 = gelu_f(lo_f(uv.x)), u1 = gelu_f(hi_f(uv.x)), u2 = gelu_f(lo_f(uv.y)), u3 = gelu_f(hi_f(uv.y));
          u32x2 o; o.x = pk2(u0 * (acc[dt][0] + bi), u1 * (acc[dt][1] + bi)); o.y = pk2(u2 * (acc[dt][2] + bi), u3 * (acc[dt][3] + bi));
          *(u32x2*)(MIX + m * D + 512 + h * 128 + d) = o; } }
    LBAR();
}

__device__ __forceinline__ void sample_item(unsigned char* lds, const float* PS  , const float* BA, const float* cw, float alog, float dtb, const float* stq, const float* S0, float* S1, float* qkvconv_out,
                                            float* sguv_out, const float* gdn, const float* sgn, float w00, float b0, bf16_t* MIX, int b, int h, int tid) {
    asm volatile("" : "+v"(tid));
    float* sq = (float*)lds; float* sk = sq + 128; float* sv = sq + 256; float* svn = sq + 384; float* so = sq + 512; float* ssc = sq + 640; float* redk = sq + 656; float* redq = redk + 2048;
    float* srow = redq + 2048;
    const int lane = tid & 63;
    const size_t m = (size_t)MP + b;
    const int dv4 = (tid & 31) * 4, kr = tid >> 5;
    f32x4 s0[8];
#pragma unroll
    for (int r = 0; r < 8; ++r) s0[r] = *(const f32x4*)(S0 + (kr + 16 * r) * 128 + dv4);
    for (int c4 = tid; c4 < NIN_G / 4; c4 += NTHR) { f32x4 a = *(const f32x4*)(PS + (size_t)b * NIN_G + 4 * c4);
#pragma unroll
        for (int ks = 1; ks < 4; ++ks) a += *(const f32x4*)(PS + ((size_t)ks * SB + b) * NIN_G + 4 * c4);
        *(f32x4*)(srow + 4 * c4) = a; }
    LBAR();
    if (tid < 64) {
        const int tensor = tid >> 4, grp = tid & 15; const bool act = tensor < 3;
        const int ch = (act ? tensor : 0) * 512 + h * 128 + grp * 8;
        float x[8];
        { const f32x4 x0 = *(const f32x4*)(srow + ch), x1 = *(const f32x4*)(srow + ch + 4); x[0] = x0.x; x[1] = x0.y; x[2] = x0.z; x[3] = x0.w; x[4] = x1.x; x[5] = x1.y; x[6] = x1.z; x[7] = x1.w; }
        float y[8];
        { const f32x4 w0 = *(const f32x4*)(cw + 3 * QKVD + ch), w1 = *(const f32x4*)(cw + 3 * QKVD + ch + 4);
          y[0] = w0.x * x[0]; y[1] = w0.y * x[1]; y[2] = w0.z * x[2]; y[3] = w0.w * x[3]; y[4] = w1.x * x[4]; y[5] = w1.y * x[5]; y[6] = w1.z * x[6]; y[7] = w1.w * x[7]; }
#pragma unroll
        for (int r = 0; r < 3; ++r) { const f32x4 s0 = *(const f32x4*)(stq + r * QKVD + ch), s1 = *(const f32x4*)(stq + r * QKVD + ch + 4);
            const f32x4 w0 = *(const f32x4*)(cw + r * QKVD + ch), w1 = *(const f32x4*)(cw + r * QKVD + ch + 4);
            y[0] += w0.x * s0.x; y[1] += w0.y * s0.y; y[2] += w0.z * s0.z; y[3] += w0.w * s0.w; y[4] += w1.x * s1.x; y[5] += w1.y * s1.y; y[6] += w1.z * s1.z; y[7] += w1.w * s1.w;
            if (act && r >= 1) { *(f32x4*)(qkvconv_out + (r - 1) * QKVD + ch) = s0; *(f32x4*)(qkvconv_out + (r - 1) * QKVD + ch + 4) = s1; } }
        if (act) { *(f32x4*)(qkvconv_out + 2 * QKVD + ch) = (f32x4){x[0], x[1], x[2], x[3]}; *(f32x4*)(qkvconv_out + 2 * QKVD + ch + 4) = (f32x4){x[4], x[5], x[6], x[7]}; }
        float ss = 0.f;
#pragma unroll
        for (int e = 0; e < 8; ++e) { y[e] = silu_f(y[e]); ss += y[e] * y[e]; }
        ss = sum16(ss);
        float rn = 1.f;
        if (tensor == 0) rn = __builtin_amdgcn_rsqf(ss + EPS) * 0.08838834764831845f; else if (tensor == 1) rn = __builtin_amdgcn_rsqf(ss + EPS);
        if (act) { float* dst = tensor == 0 ? sq : (tensor == 1 ? sk : sv);
#pragma unroll
            for (int e = 0; e < 8; ++e) dst[grp * 8 + e] = y[e] * rn; }
        { float pq = 0.f;
#pragma unroll
          for (int e = 0; e < 8; ++e) { const float kk = __shfl(y[e] * rn, (lane + 16) & 63); pq += y[e] * rn * kk; }
          pq = sum16(pq); if (tid == 0) ssc[2] = pq; }
        if (tid == 0) { const float braw = BA[m * 8 + h], araw = BA[m * 8 + 4 + h]; ssc[0] = 1.f / (1.f + __expf(-braw)); ssc[1] = __expf(-__expf(alog) * softplus_f(araw + dtb)); }
    }
    LBAR();
    const float beta = ssc[0], eg = ssc[1];
    f32x4 pk = {0.f, 0.f, 0.f, 0.f}, pq = {0.f, 0.f, 0.f, 0.f};
#pragma unroll
    for (int r = 0; r < 8; ++r) { const int kk = kr + 16 * r; pk += s0[r] * sk[kk]; pq += s0[r] * sq[kk]; }
    *(f32x4*)(redk + kr * 128 + dv4) = pk; *(f32x4*)(redq + kr * 128 + dv4) = pq;
    LBAR();
    if (tid < 128) { float kS = 0.f, qS = 0.f;
#pragma unroll
        for (int r = 0; r < 16; ++r) { kS += redk[r * 128 + tid]; qS += redq[r * 128 + tid]; }
        const float qk = ssc[2];
        const float vn = beta * (sv[tid] - eg * kS); svn[tid] = vn; so[tid] = eg * qS + qk * vn; }
    LBAR();
    { const f32x4 vn4 = *(const f32x4*)(svn + dv4);
#pragma unroll
      for (int r = 0; r < 8; ++r) { const int kk = kr + 16 * r; *(f32x4*)(S1 + kk * 128 + dv4) = s0[r] * eg + vn4 * sk[kk]; } }
    if (tid < 64) { const int d0 = 2 * lane; const float o0 = so[d0], o1 = so[d0 + 1];
        const float ss = wave_sum(o0 * o0 + o1 * o1); const float rn = __builtin_amdgcn_rsqf(ss * (1.f / 128.f) + EPS);
        const float z0 = srow[PC_Z + h * 128 + d0], z1 = srow[PC_Z + h * 128 + d0 + 1];
        *(unsigned*)(MIX + m * D + h * 128 + d0) = pk2(o0 * rn * gdn[d0] * silu_f(z0), o1 * rn * gdn[d0 + 1] * silu_f(z1)); }
    else if (tid < 128) { const int d0 = 2 * lane;
        const float g0 = gelu_f(srow[PC_VB + h * 128 + d0]), g1 = gelu_f(srow[PC_VB + h * 128 + d0 + 1]);
        const float ss = wave_sum(g0 * g0 + g1 * g1); const float rn = __builtin_amdgcn_rsqf(ss * (1.f / 128.f) + EPS);
        const float v0 = g0 * rn * sgn[d0], v1 = g1 * rn * sgn[d0 + 1];
        sguv_out[d0] = v0; sguv_out[d0 + 1] = v1;
        *(unsigned*)(MIX + m * D + 512 + h * 128 + d0) = pk2(gelu_f(srow[PC_U + h * 128 + d0]) * (w00 * v0 + b0), gelu_f(srow[PC_U + h * 128 + d0 + 1]) * (w00 * v1 + b0)); }
    LBAR();
}

__device__ __forceinline__ bf16x8 ld2(const bf16_t* p0, const bf16_t* p1) { const u32x2 a = *(const u32x2*)p0, b = *(const u32x2*)p1; u32x4 r; r.x = a.x; r.y = a.y; r.z = b.x; r.w = b.y; return __builtin_bit_cast(bf16x8, r); }
__device__ __forceinline__ bf16x8 packacc(const f32x4 a, const f32x4 b) { u32x4 r; r.x = pk2(a[0], a[1]); r.y = pk2(a[2], a[3]); r.z = pk2(b[0], b[1]); r.w = pk2(b[2], b[3]); return __builtin_bit_cast(bf16x8, r); }
constexpr int SC_NC = 2, SC_UT = 62464, SC_UTB = SC_NC * 2304, SC_EG = SC_UT + SC_UTB, SC_BUF = SC_EG + 128;
constexpr int SC_NLD = 256, SC_NQ = 16, SC_SLOT = 2 * SC_BUF, SC_SLOTV = SC_SLOT + SC_NC * 4096;
static_assert(SC_SLOTV + SC_NC * 2048 <= LDS_BYTES - 64 && SC_BUF % 16 == 0, "scan lds");
__device__ __forceinline__ bf16x8 ld2s(const bf16_t* p0) { const u32x2 a = *(const u32x2*)p0, b = *(const u32x2*)(p0 + 16); u32x4 r; r.x = a.x; r.y = a.y; r.z = b.x; r.w = b.y; return __builtin_bit_cast(bf16x8, r); }
struct ScanRegs { u32x4 r[SC_NQ]; u32x4 ru[2]; float eg; };
__device__ __forceinline__ void scan_issue(ScanRegs& R, const unsigned char* dr, int dv0, int lt) {
    const u32x4* g = (const u32x4*)dr;
#pragma unroll
    for (int q = 0; q < SC_NQ; ++q) { const int i = lt + SC_NLD * q; if (q < SC_NQ - 1 || lt < 3904 - SC_NLD * (SC_NQ - 1)) R.r[q] = g[i]; }
    const u32x4* gu = (const u32x4*)(dr + DR_UT + dv0 * 144);
    R.ru[0] = gu[lt]; if (lt < SC_UTB / 16 - 256) R.ru[1] = gu[lt + 256];
    if (lt == 0) R.eg = *(const float*)(dr + DR_EG);
}
__device__ __forceinline__ void scan_commit(const ScanRegs& R, unsigned char* buf, int lt) {
#pragma unroll
    for (int q = 0; q < SC_NQ; ++q) { const int i = lt + SC_NLD * q; if (q < SC_NQ - 1 || lt < 3904 - SC_NLD * (SC_NQ - 1)) ((u32x4*)buf)[i] = R.r[q]; }
    ((u32x4*)(buf + SC_UT))[lt] = R.ru[0]; if (lt < SC_UTB / 16 - 256) ((u32x4*)(buf + SC_UT))[lt + 256] = R.ru[1];
    if (lt == 0) *(float*)(buf + SC_EG) = R.eg;
}
constexpr int SCAN_ITEMS = 32 * (128 / (16 * SC_NC));
#define SCAN_BAR() do { asm volatile("s_waitcnt lgkmcnt(0)" ::: "memory"); __builtin_amdgcn_s_barrier(); asm volatile("" ::: "memory"); } while (0)
__device__ __forceinline__ void scan_item(unsigned char* lds, const unsigned char* drbase, float* OBUF, float* Sout, int item, int tid) {
    asm volatile("" : "+v"(tid));
    const int lane = tid & 63, wave = __builtin_amdgcn_readfirstlane(tid >> 6);
    constexpr int NSL = 128 / (16 * SC_NC);
    const int bh = item / NSL, cs = item % NSL, b = bh >> 2, h = bh & 3, dv0 = 16 * SC_NC * cs, fr = lane & 15, fq = lane >> 4;
    const unsigned char* dr0 = drbase + (size_t)((b * 32) * 4 + h) * DR_STRIDE;
    const bool ldr = wave >= 4; const int lt = tid - 256, w = wave;
    f32x4 S0[SC_NC], S1[SC_NC];
#pragma unroll
    for (int c = 0; c < SC_NC; ++c) { S0[c] = (f32x4){0.f, 0.f, 0.f, 0.f}; S1[c] = (f32x4){0.f, 0.f, 0.f, 0.f}; }
    if (ldr) {
        ScanRegs R0, R1, R2;
#pragma unroll
        for (int q = 0; q < SC_NQ; ++q) { R0.r[q] = (u32x4){0u, 0u, 0u, 0u}; R1.r[q] = (u32x4){0u, 0u, 0u, 0u}; R2.r[q] = (u32x4){0u, 0u, 0u, 0u}; }
        R0.ru[0] = R0.ru[1] = R1.ru[0] = R1.ru[1] = R2.ru[0] = R2.ru[1] = (u32x4){0u, 0u, 0u, 0u}; R0.eg = R1.eg = R2.eg = 0.f;
        scan_issue(R0, dr0, dv0, lt); scan_commit(R0, lds, lt);
        scan_issue(R1, dr0 + (size_t)1 * 4 * DR_STRIDE, dv0, lt); scan_issue(R2, dr0 + (size_t)2 * 4 * DR_STRIDE, dv0, lt); scan_issue(R0, dr0 + (size_t)3 * 4 * DR_STRIDE, dv0, lt);
        SCAN_BAR();
#define SCAN_LSTEP(S_, R_) do { const int s_ = (S_); if (s_ < 32) { if (s_ + 1 < 32) scan_commit(R_, lds + ((s_ + 1) & 1) * SC_BUF, lt); \
            if (s_ + 4 < 32) scan_issue(R_, dr0 + (size_t)(s_ + 4) * 4 * DR_STRIDE, dv0, lt); SCAN_BAR(); SCAN_BAR(); } } while (0)
#pragma unroll 1
        for (int s3 = 0; s3 < 33; s3 += 3) { SCAN_LSTEP(s3, R1); SCAN_LSTEP(s3 + 1, R2); SCAN_LSTEP(s3 + 2, R0); }
#undef SCAN_LSTEP
    } else {
    { unsigned vz; asm volatile("v_mov_b32 %0, 0" : "=v"(vz));
#pragma unroll
        for (int c = 0; c < SC_NC; ++c) *(u32x4*)(lds + SC_SLOT + (c * 4 + w) * 1024 + lane * 16) = (u32x4){vz, vz, vz, vz}; }
    SCAN_BAR();
#pragma unroll 1
    for (int ci = 0; ci < 32; ++ci) {
        const unsigned char* buf = lds + (ci & 1) * SC_BUF;
        const bf16_t* NW = (const bf16_t*)(buf + DR_NW); const bf16_t* QG = (const bf16_t*)(buf + DR_QG); const bf16_t* QK = (const bf16_t*)(buf + DR_QK);
        const bf16_t* KDT = (const bf16_t*)(buf + DR_KDT); const bf16_t* UT = (const bf16_t*)(buf + SC_UT);
        f32x4 o[SC_NC];
#pragma unroll
        for (int c = 0; c < SC_NC; ++c) o[c] = (f32x4){0.f, 0.f, 0.f, 0.f};
        {
            bf16x8 an[4], aq[4];
#pragma unroll
            for (int kp = 0; kp < 4; ++kp) { const int off = (16 * w + fr) * 136 + 32 * kp + 4 * fq; an[kp] = ld2s(NW + off); aq[kp] = ld2s(QG + off); }
#pragma unroll
            for (int c = 0; c < SC_NC; ++c) {
                bf16x8 sb[4];
#pragma unroll
                for (int kp = 0; kp < 4; ++kp) sb[kp] = *(const bf16x8*)(lds + SC_SLOT + (c * 4 + kp) * 1024 + lane * 16);
                f32x4 vn; { const u32x2 uv = *(const u32x2*)(UT + (16 * c + fr) * 72 + 16 * w + 4 * fq); vn = (f32x4){lo_f(uv.x), hi_f(uv.x), lo_f(uv.y), hi_f(uv.y)}; }
#pragma unroll
                for (int kp = 0; kp < 4; ++kp) vn = MFMA16(an[kp], sb[kp], vn);
                { u32x2 pv; pv.x = pk2(vn[0], vn[1]); pv.y = pk2(vn[2], vn[3]); *(u32x2*)(lds + SC_SLOTV + (c * 4 + w) * 512 + lane * 8) = pv; }
#pragma unroll
                for (int kp = 0; kp < 4; ++kp) o[c] = MFMA16(aq[kp], sb[kp], o[c]);
            }
        }
        SCAN_BAR();
        {
            const float eg = *(const float*)(buf + SC_EG);
            bf16x8 aqk[2], akd[2][2];
#pragma unroll
            for (int p = 0; p < 2; ++p) { aqk[p] = ld2s(QK + (16 * w + fr) * 72 + 32 * p + 4 * fq);
#pragma unroll
                for (int t = 0; t < 2; ++t) akd[t][p] = ld2s(KDT + (16 * (2 * w + t) + fr) * 72 + 32 * p + 4 * fq); }
#pragma unroll
            for (int c = 0; c < SC_NC; ++c) {
                bf16x8 vb[2];
#pragma unroll
                for (int p = 0; p < 2; ++p) { const u32x2 a = *(const u32x2*)(lds + SC_SLOTV + (c * 4 + 2 * p) * 512 + lane * 8), d = *(const u32x2*)(lds + SC_SLOTV + (c * 4 + 2 * p + 1) * 512 + lane * 8);
                    u32x4 r; r.x = a.x; r.y = a.y; r.z = d.x; r.w = d.y; vb[p] = __builtin_bit_cast(bf16x8, r); }
                S0[c] = S0[c] * eg; S1[c] = S1[c] * eg;
#pragma unroll
                for (int p = 0; p < 2; ++p) { S0[c] = MFMA16(akd[0][p], vb[p], S0[c]); S1[c] = MFMA16(akd[1][p], vb[p], S1[c]); o[c] = MFMA16(aqk[p], vb[p], o[c]); }
                *(u32x4*)(lds + SC_SLOT + (c * 4 + w) * 1024 + lane * 16) = __builtin_bit_cast(u32x4, packacc(S0[c], S1[c]));
                float* ob = OBUF + ((size_t)b * T + (size_t)ci * 64) * 512 + h * 128 + dv0 + 16 * c + fr;
#pragma unroll
                for (int jj = 0; jj < 4; ++jj) ob[(size_t)(16 * w + 4 * fq + jj) * 512] = o[c][jj];
            }
        }
        SCAN_BAR();
    }
    }
    if (!ldr) {
#pragma unroll
        for (int c = 0; c < SC_NC; ++c) { float* so = Sout + (size_t)(b * 4 + h) * 128 * 128 + dv0 + 16 * c + fr;
#pragma unroll
            for (int jj = 0; jj < 4; ++jj) { so[(32 * w + 4 * fq + jj) * 128] = S0[c][jj]; so[(32 * w + 16 + 4 * fq + jj) * 128] = S1[c][jj]; } }
    }
}

__device__ __forceinline__ void phase_gnorm(const float* OBUF, const bf16_t* P, const float* gdn, bf16_t* MIX, int gw, int ngw, int lane) {
    const int d = (8 * lane) & 127;
    const f32x4 g0 = *(const f32x4*)(gdn + d), g1 = *(const f32x4*)(gdn + d + 4);
    f32x4 an = {0.f, 0.f, 0.f, 0.f}, cn = {0.f, 0.f, 0.f, 0.f}; u32x4 zn = {0u, 0u, 0u, 0u};
    if (gw < MP) { an = *(const f32x4*)(OBUF + (size_t)gw * 512 + 8 * lane); cn = *(const f32x4*)(OBUF + (size_t)gw * 512 + 8 * lane + 4); zn = *(const u32x4*)(P + (size_t)gw * NINP + PC_Z + 8 * lane); }
    for (int m = gw; m < MP; m += ngw) {
        const f32x4 a = an, c = cn; const u32x4 zv = zn;
        { const int mn = m + ngw; if (mn < MP) { an = *(const f32x4*)(OBUF + (size_t)mn * 512 + 8 * lane); cn = *(const f32x4*)(OBUF + (size_t)mn * 512 + 8 * lane + 4); zn = *(const u32x4*)(P + (size_t)mn * NINP + PC_Z + 8 * lane); } }
        float ss = (a.x * a.x + a.y * a.y) + (a.z * a.z + a.w * a.w) + (c.x * c.x + c.y * c.y) + (c.z * c.z + c.w * c.w);
        ss = sum16(ss);
        const float rn = __builtin_amdgcn_rsqf(ss * (1.f / 128.f) + EPS);
        float z[8]; unpack8(zv, z);
        u32x4 o; o.x = pk2(a.x * rn * g0.x * silu_f(z[0]), a.y * rn * g0.y * silu_f(z[1])); o.y = pk2(a.z * rn * g0.z * silu_f(z[2]), a.w * rn * g0.w * silu_f(z[3]));
        o.z = pk2(c.x * rn * g1.x * silu_f(z[4]), c.y * rn * g1.y * silu_f(z[5])); o.w = pk2(c.z * rn * g1.z * silu_f(z[6]), c.w * rn * g1.w * silu_f(z[7]));
        *(u32x4*)(MIX + (size_t)m * D + 8 * lane) = o;
    }
}

__device__ __forceinline__ void ld8f(const float* p, float (&x)[8]) { const f32x4 a = *(const f32x4*)p, b = *(const f32x4*)(p + 4); x[0] = a.x; x[1] = a.y; x[2] = a.z; x[3] = a.w; x[4] = b.x; x[5] = b.y; x[6] = b.z; x[7] = b.w; }
__device__ __forceinline__ void st8f(float* p, const float (&x)[8]) { *(f32x4*)p = (f32x4){x[0], x[1], x[2], x[3]}; *(f32x4*)(p + 4) = (f32x4){x[4], x[5], x[6], x[7]}; }
__device__ __forceinline__ void phase_fixup(const float* RAW, const float* UPS, const float* cwf, const float* cbf, const float* stf, bf16_t* ACT, float* outp, float* outs, int gtid, int ngt) {
    constexpr int NSL = MP / 64;
    for (int idx = gtid; idx < (NSL * 2 + SB) * 352; idx += ngt) {
        const int rowi = idx / 352, c = (idx % 352) * 8;
        const int pn = c >> 7, cc = c & 127, cga = 256 * pn + cc;
        float r0[2][8], r1[2][8], r2[2][8];
        int m;
        if (rowi < NSL * 2) { const int s = rowi >> 1, q = rowi & 1; m = 64 * s + q; const bool first = (s & 31) == 0;
#pragma unroll
            for (int hf = 0; hf < 2; ++hf) { const int cg = cga + 128 * hf;
                const float* rs = RAW + (size_t)s * 4 * NUP + cg; const float* rp = RAW + (size_t)(s - 1) * 4 * NUP + cg;
#pragma unroll
                for (int e = 0; e < 8; ++e) { r0[hf][e] = 0.f; r1[hf][e] = 0.f; }
                if (q == 0) { ld8f(rs, r2[hf]); if (!first) { ld8f(rp + 2 * NUP, r0[hf]); ld8f(rp + 3 * NUP, r1[hf]); } }
                else { ld8f(rs + NUP, r2[hf]); ld8f(rs, r1[hf]); if (!first) ld8f(rp + 3 * NUP, r0[hf]); }
                if ((s & 31) == 31) { float t[8]; ld8f(rs + (size_t)(2 + q) * NUP, t); st8f(outp + ((size_t)(s >> 5) * 2 + q) * NUP + hf * DFF + c, t); } }
        } else { const int bs = rowi - NSL * 2; m = MP + bs;
#pragma unroll
            for (int hf = 0; hf < 2; ++hf) { const int cg = cga + 128 * hf, co = c + hf * DFF; const float* s = stf + (size_t)bs * 2 * NUP + co;
                ld8f(s, r0[hf]); ld8f(s + NUP, r1[hf]);
                f32x4 a0 = {0.f, 0.f, 0.f, 0.f}, a1 = {0.f, 0.f, 0.f, 0.f};
                { const float* qp = UPS + (size_t)bs * NUP + cg; a0 = *(const f32x4*)qp; a1 = *(const f32x4*)(qp + 4); }
                r2[hf][0] = a0.x; r2[hf][1] = a0.y; r2[hf][2] = a0.z; r2[hf][3] = a0.w; r2[hf][4] = a1.x; r2[hf][5] = a1.y; r2[hf][6] = a1.z; r2[hf][7] = a1.w;
                float* o = outs + (size_t)bs * 2 * NUP + co; st8f(o, r1[hf]); st8f(o + NUP, r2[hf]); } }
        float v[2][8];
#pragma unroll
        for (int hf = 0; hf < 2; ++hf) { const int co = c + hf * DFF; float w0[8], w1[8], w2[8], bb[8];
            ld8f(cwf + co, w0); ld8f(cwf + NUP + co, w1); ld8f(cwf + 2 * NUP + co, w2); ld8f(cbf + co, bb);
#pragma unroll
            for (int e = 0; e < 8; ++e) v[hf][e] = w0[e] * r0[hf][e] + w1[e] * r1[hf][e] + w2[e] * r2[hf][e] + bb[e]; }
        float o[8];
#pragma unroll
        for (int e = 0; e < 8; ++e) o[e] = silu_f(v[0][e]) * v[1][e];
        *(u32x4*)(ACT + (size_t)m * DFF + c) = pack8(o);
    }
}

#define LAS __attribute__((address_space(3)))
#define XB_TMO      128
#define XB_XCNT(j)  (256  + 64 * (j))
#define XB_XSUB(j)  (1280 + 64 * (j))
#define XB_XGEN(j)  (2304 + 64 * (j))
#define XB_TOP      3328
#define XB_TOPGEN   3392
#define XCD_BAR_WORDS 3456
#define XB_SPIN_CAP (1u << 18)

__device__ __forceinline__ unsigned xb_ld(unsigned* p)              { return __hip_atomic_load(p, __ATOMIC_RELAXED, __HIP_MEMORY_SCOPE_AGENT); }
__device__ __forceinline__ unsigned xb_add(unsigned* p, unsigned v) { return __hip_atomic_fetch_add(p, v, __ATOMIC_RELAXED, __HIP_MEMORY_SCOPE_AGENT); }
__device__ __forceinline__ unsigned xb_xcc_id() { return (unsigned)__builtin_amdgcn_s_getreg((3 << 11) | 20) & 0xFu; }
#define XB_SPIN(cond, bar) do { unsigned _sp = 0; while (cond) { __builtin_amdgcn_s_sleep(1); \
    if ((++_sp & 255u) == 0u) { if (xb_ld(&(bar)[XB_TMO])) break; if (_sp > XB_SPIN_CAP) { atomicAdd(&(bar)[XB_TMO], 1u); break; } } } } while (0)

struct XcdBarrier {
    unsigned* bar; unsigned x;
    volatile LAS unsigned* st;
};

__device__ __forceinline__ XcdBarrier xcd_barrier_post(unsigned* bar, volatile LAS unsigned* st) {
    XcdBarrier b; b.bar = bar; b.x = xb_xcc_id(); b.st = st;
    if (threadIdx.x == 0) (void)xb_add(&bar[XB_XCNT(b.x)], 1u);
    return b;
}
__device__ __forceinline__ void xcd_barrier_complete(unsigned* bar, unsigned x, unsigned& nloc, unsigned& nx) {
    const unsigned G = gridDim.x * gridDim.y * gridDim.z;
    unsigned sum, cnt, mine, sp = 0u;
    for (;;) {
        sum = 0u; cnt = 0u; mine = 0u;
#pragma unroll
        for (unsigned j = 0; j < 16; ++j) { const unsigned c = xb_ld(&bar[XB_XCNT(j)]); sum += c; cnt += (c > 0u) ? 1u : 0u; mine = (j == x) ? c : mine; }
        if (sum == G) break;
        __builtin_amdgcn_s_sleep(1);
        if ((++sp & 255u) == 0u) { if (xb_ld(&bar[XB_TMO])) break; if (sp > XB_SPIN_CAP) { atomicAdd(&bar[XB_TMO], 1u); break; } }
    }
    nloc = mine > 0u ? mine : 1u; nx = cnt > 0u ? cnt : 1u;
}

__device__ __forceinline__ void xcd_barrier(const XcdBarrier& b) {
    asm volatile("s_waitcnt vmcnt(0)" ::: "memory");
    __syncthreads();
    if (threadIdx.x == 0) {
        unsigned* bar = b.bar;
        __builtin_amdgcn_s_waitcnt(0);
        unsigned nloc = b.st[0], nx = b.st[1];
        if (nloc == 0u) { xcd_barrier_complete(bar, b.x, nloc, nx); b.st[0] = nloc; b.st[1] = nx; }
        const unsigned old = xb_add(&bar[XB_XSUB(b.x)], 1u);
        const unsigned gen = old / nloc;
        if (old + 1u == (gen + 1u) * nloc) {
            __builtin_amdgcn_fence(__ATOMIC_RELEASE, "agent");
            asm volatile("s_waitcnt vmcnt(0)" ::: "memory");
            const unsigned og = xb_add(&bar[XB_TOP], 1u);
            const unsigned tg = og / nx;
            if (og + 1u == (tg + 1u) * nx) xb_add(&bar[XB_TOPGEN], 1u);
            else XB_SPIN(xb_ld(&bar[XB_TOPGEN]) == tg, bar);
            __builtin_amdgcn_fence(__ATOMIC_ACQUIRE, "agent");
            xb_add(&bar[XB_XGEN(b.x)], 1u);
            asm volatile("s_waitcnt vmcnt(0)" ::: "memory");
        } else {
            XB_SPIN(xb_ld(&bar[XB_XGEN(b.x)]) == gen, bar);
            __builtin_amdgcn_fence(__ATOMIC_ACQUIRE, "agent");
            asm volatile("s_waitcnt vmcnt(0)" ::: "memory");
        }
    }
    __syncthreads();
}

struct Args { const float* in[25]; float* out; unsigned char* ws; int ph_lo, ph_hi; };
constexpr int N_PHASES = 2 + 10 * DEPTH + 1;

#define MOD ((float*)(wsl + WS_MOD))
#define XR ((float*)(wsl + WS_XR))
#define AB ((bf16_t*)(wsl + WS_AB))
#define PB ((bf16_t*)(wsl + WS_BIG))
#define OBUF ((float*)(wsl + WS_OBUF))
#define ACT ((bf16_t*)(wsl + WS_ACT))
#define PSb ((float*)(wsl + WS_PS))
#define UPSb ((float*)(wsl + WS_UPS))
#define RPb ((float*)(wsl + WS_RP))
#define BAb ((float*)(wsl + WS_BA))
#define wl ((const unsigned char*)(wsl + WS_W + (size_t)l * WL_STRIDE))
#define modl ((const float*)(MOD + l * NMOD))
__global__ void __launch_bounds__(NTHR, 2) fwd_kernel(Args args) {
    extern __shared__ __attribute__((aligned(16))) unsigned char lds[];
    cg::grid_group grid = cg::this_grid();
    const int G = gridDim.x, bx = blockIdx.x, ngw = G * NWAVES;
#define TIDS() int tid = threadIdx.x; asm volatile("" : "+v"(tid)); const int lane = tid & 63, wave = __builtin_amdgcn_readfirstlane(tid >> 6), gw = bx * NWAVES + wave; (void)lane; (void)wave; (void)gw
    unsigned char* ws = args.ws;
    const int lo = args.ph_lo, hi = args.ph_hi;
#ifndef PMASK
#define PMASK 0xFFFF
#endif
#define RUN(k) (lo <= (k) && (k) < hi)
#define EN(b) ((PMASK >> (b)) & 1)
#ifndef REPMASK
#define REPMASK 0
#endif
#ifndef NREP
#define NREP 2
#endif
#define GSYNC() xcd_barrier(xbar)
#define SEAM(k) do { if (RUN(k) && RUN((k) + 1)) GSYNC(); } while (0)
    PG8_LAS unsigned char* glds = (PG8_LAS unsigned char*)lds;
    volatile LAS unsigned* MISC = (volatile LAS unsigned*)(glds + (LDS_BYTES - 64));
    if (threadIdx.x < 16) MISC[threadIdx.x] = 0u;
    __syncthreads();
    XcdBarrier xbar; xbar.bar = (unsigned*)ws; xbar.x = 0; xbar.st = nullptr;
    if (hi - lo > 1) xbar = xcd_barrier_post((unsigned*)ws, MISC + 8);
    if (hi < lo) grid.sync();

    if (EN(10) && RUN(0)) for (int rep_ = 0; rep_ < 1 + NREP * ((REPMASK >> 10) & 1); ++rep_) { if (rep_) GSYNC(); unsigned char* wsl = args.ws; asm volatile("" : "+s"(wsl)); TIDS(); phase_convert(lds, wsl, args.in[10], args.in[18], args.in[20], args.in[23], args.in[7], args.in[5], args.in[6], gw, ngw, wave, lane); }
    SEAM(0);
    if (EN(11) && RUN(1)) for (int rep_ = 0; rep_ < 1 + NREP * ((REPMASK >> 11) & 1); ++rep_) { if (rep_) GSYNC(); unsigned char* wsl = args.ws; asm volatile("" : "+s"(wsl)); pg8::Gemm g{(const bf16_t*)(wsl + WS_CACT), (const bf16_t*)(wsl + WS_WMODT), 256, MODLD, D, D}; pg8::StaticOrder S; S.init(256, MODLD, G, bx);
        EpiMod E{MOD, args.in[8]}; pg8::gemm_phase<EpiMod, pg8::StaticOrder>(glds, g, S, E, nullptr); }
    SEAM(1);
#pragma unroll 1
    for (int l = 0; l < DEPTH; ++l) {
        const int pb = 2 + 10 * l;
        if (EN(0) && RUN(pb + 0)) for (int rep_ = 0; rep_ < 1 + NREP * ((REPMASK >> 0) & 1); ++rep_) { if (rep_) GSYNC(); unsigned char* wsl = args.ws; asm volatile("" : "+s"(wsl)); TIDS();
            fill_tba((float*)lds, args.in[10] + (size_t)l * D * NIN, tid);
            if (l == 0) phase_ln(args.in[0], args.in[1], args.in[9], modl + 0 * D, modl + 1 * D, AB, XR, nullptr, 0, nullptr, nullptr, (const f32x4*)lds, BAb, gw, ngw, lane);
            else phase_ln(XR, XR + (size_t)MP * D, args.in[9] + l * D, modl + 0 * D, modl + 1 * D, AB, nullptr, RPb, 11, modl - NMOD + 5 * D, XR, (const f32x4*)lds, BAb, gw, ngw, lane);
            __syncthreads();
        }
        SEAM(pb + 0);
        if (EN(1) && RUN(pb + 1)) for (int rep_ = 0; rep_ < 1 + NREP * ((REPMASK >> 1) & 1); ++rep_) { if (rep_) GSYNC(); unsigned char* wsl = args.ws; asm volatile("" : "+s"(wsl)); pg8::Gemm g{AB, (const bf16_t*)(wl + WL_IN), MP, NIN_G, D, D}; pg8::StaticOrder S; S.init(MP, NIN_G, G, bx);
            EpiBf E{PB, NINP}; pg8::gemm_phase<EpiBf, pg8::StaticOrder>(glds, g, S, E, nullptr);
            { pg8::Gemm g2{AB, (const bf16_t*)(wl + WL_IN), MPAD, NIN_G, 256, D}; pg8::SplitOrder S2; S2.init(NIN_G, 4, 256, MP / 256, G, bx);
              EpiPart E2{PSb, NIN_G, 256}; pg8::gemm_phase<EpiPart, pg8::SplitOrder>(glds, g2, S2, E2, nullptr); } }
        SEAM(pb + 1);
        if (EN(2) && RUN(pb + 2)) for (int rep_ = 0; rep_ < 1 + NREP * ((REPMASK >> 2) & 1); ++rep_) { if (rep_) GSYNC(); unsigned char* wsl = args.ws; asm volatile("" : "+s"(wsl)); TIDS();
            const float* cw = args.in[11] + (size_t)l * 4 * QKVD;
            {
                PrepIn pa, pn;
                if (bx < 1024) prep_fetch(pa, PB, BAb, bx >> 7, (bx >> 2) & 31, bx & 3, tid);
#pragma unroll 1
                for (int it = bx; it < 1024; it += G) { const int h = it & 3, ci = (it >> 2) & 31, b = it >> 7; const int nit = it + G; const bool hn = nit < 1024;
                    prep_item(lds, PB, BAb, cw, args.in[12][l * 4 + h], args.in[13][l * 4 + h], wsl + WS_ACT + (size_t)it * DR_STRIDE,
                              ci == 31 ? args.out + O_QP + ((size_t)l * NB + b) * 3 * QKVD : nullptr, b, ci, h, tid, pa, pn, hn, nit >> 7, (nit >> 2) & 31, nit & 3);
                    pa = pn; }
            }
            for (int it = 1024 + bx; it < 1280; it += G) { const int j = it - 1024, h = j & 3, n = (j >> 2) & 15, b = j >> 6;
                sgu_item(lds, PB, args.in[16] + ((size_t)l * 4 + h) * 128 * 128, args.in[17] + (l * 4 + h) * 128, args.in[15] + (l * 4 + h) * 128, AB, b, n, h, tid); }
        }
        SEAM(pb + 2);
        if (EN(3) && RUN(pb + 3)) for (int rep_ = 0; rep_ < 1 + NREP * ((REPMASK >> 3) & 1); ++rep_) { if (rep_) GSYNC(); unsigned char* wsl = args.ws; asm volatile("" : "+s"(wsl)); TIDS(); const int nscan = SCAN_ITEMS < G ? SCAN_ITEMS : G, nrest = G - nscan;
            if (bx < nscan) for (int v = bx; v < SCAN_ITEMS; v += nscan) { const int nsl = SCAN_ITEMS / 32, xcd = v & 7, j = v >> 3, it = (xcd * 4 + j / nsl) * nsl + (j % nsl);
                scan_item(lds, wsl + WS_ACT, OBUF, args.out + O_DP + (size_t)l * NB * 4 * 128 * 128, it, tid); }
            if (nrest == 0 || bx >= nscan) { const int r0 = nrest ? bx - nscan : bx, rs = nrest ? nrest : G;
            const float* cw = args.in[11] + (size_t)l * 4 * QKVD;
            for (int it = 1280 + r0; it < 2048; it += rs) {
                if (it < 1536) { const int j = it - 1024, h = j & 3, n = (j >> 2) & 15, b = j >> 6;
                    sgu_item(lds, PB, args.in[16] + ((size_t)l * 4 + h) * 128 * 128, args.in[17] + (l * 4 + h) * 128, args.in[15] + (l * 4 + h) * 128, AB, b, n, h, tid); }
                else { const int j = it - 1536, h = j & 3, b = j >> 2;
                    sample_item(lds, PSb, BAb, cw, args.in[12][l * 4 + h], args.in[13][l * 4 + h], args.in[3] + ((size_t)l * SB + b) * 3 * QKVD,
                                args.in[2] + (((size_t)l * SB + b) * 4 + h) * 128 * 128, args.out + O_DS + (((size_t)l * SB + b) * 4 + h) * 128 * 128,
                                args.out + O_QS + ((size_t)l * SB + b) * 3 * QKVD, args.out + O_SV + (((size_t)l * SB + b) * 4 + h) * 128,
                                args.in[14] + l * 128, args.in[15] + (l * 4 + h) * 128, args.in[16][((size_t)l * 4 + h) * 128 * 128], args.in[17][(l * 4 + h) * 128], AB, b, h, tid); }
            }
            }
        }
        SEAM(pb + 3);
        if (EN(4) && RUN(pb + 4)) for (int rep_ = 0; rep_ < 1 + NREP * ((REPMASK >> 4) & 1); ++rep_) { if (rep_) GSYNC(); unsigned char* wsl = args.ws; asm volatile("" : "+s"(wsl)); TIDS(); phase_gnorm(OBUF, PB, args.in[14] + l * 128, AB, gw, ngw, lane); }
        SEAM(pb + 4);
        if (EN(5) && RUN(pb + 5)) for (int rep_ = 0; rep_ < 1 + NREP * ((REPMASK >> 5) & 1); ++rep_) { if (rep_) GSYNC(); unsigned char* wsl = args.ws; asm volatile("" : "+s"(wsl)); pg8::Gemm g{AB, (const bf16_t*)(wl + WL_OUT), MP, D, D, D}; pg8::StaticOrder S; S.init(MP, D, G, bx);
            EpiRes E{XR, rep_ ? (const float*)(wsl + 16384) : modl + 2 * D, rep_ ? 0 : MODLD}; pg8::gemm_phase<EpiRes, pg8::StaticOrder>(glds, g, S, E, nullptr);
            { pg8::Gemm g2{AB, (const bf16_t*)(wl + WL_OUT), MPAD, D, 256, D}; pg8::SplitOrder S2; S2.init(D, 4, 256, MP / 256, G, bx);
              EpiPart E2{RPb, D, 256}; pg8::gemm_phase<EpiPart, pg8::SplitOrder>(glds, g2, S2, E2, nullptr); } }
        SEAM(pb + 5);
        if (EN(6) && RUN(pb + 6)) for (int rep_ = 0; rep_ < 1 + NREP * ((REPMASK >> 6) & 1); ++rep_) { if (rep_) GSYNC(); unsigned char* wsl = args.ws; asm volatile("" : "+s"(wsl)); TIDS(); phase_ln(XR, XR + (size_t)MP * D, args.in[19] + l * D, modl + 3 * D, modl + 4 * D, AB, nullptr, RPb, 4, modl + 2 * D, XR, nullptr, nullptr, gw, ngw, lane); }
        SEAM(pb + 6);
        if (EN(7) && RUN(pb + 7)) for (int rep_ = 0; rep_ < 1 + NREP * ((REPMASK >> 7) & 1); ++rep_) { if (rep_) GSYNC(); unsigned char* wsl = args.ws; asm volatile("" : "+s"(wsl)); pg8::Gemm g{AB, (const bf16_t*)(wl + WL_UP), MPAD, NUP, D, D}; pg8::StaticOrder S; S.init(MPAD, NUP, G, bx);
            EpiUpCG E{ACT, (float*)(wsl + WS_RAW), args.in[21] + (size_t)l * 3 * NUP, args.in[22] + (size_t)l * NUP}; pg8::gemm_phase<EpiUpCG, pg8::StaticOrder>(glds, g, S, E, nullptr);
            }
        SEAM(pb + 7);
        if (EN(8) && RUN(pb + 8)) for (int rep_ = 0; rep_ < 1 + NREP * ((REPMASK >> 8) & 1); ++rep_) { if (rep_) GSYNC(); unsigned char* wsl = args.ws; asm volatile("" : "+s"(wsl)); TIDS(); phase_fixup((const float*)(wsl + WS_RAW), (const float*)(wsl + WS_UPS), args.in[21] + (size_t)l * 3 * NUP, args.in[22] + (size_t)l * NUP, args.in[4] + (size_t)l * SB * 2 * NUP, ACT,
                                        args.out + O_FP + (size_t)l * NB * 2 * NUP, args.out + O_FS + (size_t)l * SB * 2 * NUP, bx * NTHR + tid, G * NTHR); }
        SEAM(pb + 8);
        if (EN(9) && RUN(pb + 9)) for (int rep_ = 0; rep_ < 1 + NREP * ((REPMASK >> 9) & 1); ++rep_) { if (rep_) GSYNC(); unsigned char* wsl = args.ws; asm volatile("" : "+s"(wsl)); pg8::Gemm g{ACT, (const bf16_t*)(wl + WL_DOWN), MP, D, DFF, DFF}; pg8::StaticOrder S; S.init(MP, D, G, bx);
            EpiRes E{XR, rep_ ? (const float*)(wsl + 16384) : modl + 5 * D, rep_ ? 0 : MODLD}; pg8::gemm_phase<EpiRes, pg8::StaticOrder>(glds, g, S, E, nullptr);
            { pg8::Gemm g2{ACT, (const bf16_t*)(wl + WL_DOWN), MPAD, D, 256, DFF}; pg8::SplitOrder S2; S2.init(D, 11, 256, MP / 256, G, bx);
              EpiPart E2{RPb, D, 256}; pg8::gemm_phase<EpiPart, pg8::SplitOrder>(glds, g2, S2, E2, nullptr); } }
        SEAM(pb + 9);
    }
    if (EN(12) && RUN(N_PHASES - 1)) for (int rep_ = 0; rep_ < 1 + NREP * ((REPMASK >> 12) & 1); ++rep_) { if (rep_) GSYNC(); unsigned char* wsl = args.ws; asm volatile("" : "+s"(wsl)); TIDS(); phase_final(XR, args.in[24], args.out + O_Y, RPb, 11, MOD + 3 * NMOD + 5 * D, gw, ngw, lane); }
#ifdef EXTRA_SYNCS
    if (hi - lo > 1) for (int i = 0; i < EXTRA_SYNCS; ++i) GSYNC();
#endif
#undef RUN
#undef SEAM
}

#ifndef MK_MULTI
#define MK_MULTI 0
#endif
extern "C" void kernel_launch(void* const* d_in, const int* in_sizes, int n_in, void* d_out, int out_size, void* d_ws, size_t ws_size, hipStream_t stream) {
    static int grid = 0;
    if (grid == 0) {
        if (n_in != 25 || (size_t)out_size != O_END || ws_size < WS_END) { fprintf(stderr, "kernel_launch: unexpected shapes (n_in %d out %d ws %zu need %zu)\n", n_in, out_size, ws_size, (size_t)WS_END); grid = -1; return; }
        int dev = 0, cus = 0, per_cu = 0;
        hipGetDevice(&dev); hipDeviceGetAttribute(&cus, hipDeviceAttributeMultiprocessorCount, dev);
        if (hipFuncSetAttribute((const void*)fwd_kernel, hipFuncAttributeMaxDynamicSharedMemorySize, LDS_BYTES) != hipSuccess) { fprintf(stderr, "kernel_launch: hipFuncSetAttribute failed\n"); grid = -1; return; }
        if (hipOccupancyMaxActiveBlocksPerMultiprocessor(&per_cu, (const void*)fwd_kernel, NTHR, LDS_BYTES) != hipSuccess || per_cu < 1) { fprintf(stderr, "kernel_launch: occupancy query says %d\n", per_cu); per_cu = 1; }
        (void)hipGetLastError();
        grid = cus;
    }
    if (grid < 0) return;
    Args a{};
    for (int i = 0; i < 25; ++i) a.in[i] = (const float*)d_in[i];
    a.out = (float*)d_out; a.ws = (unsigned char*)d_ws;
    if (hipMemsetAsync(d_ws, 0, 32768, stream) != hipSuccess) { fprintf(stderr, "kernel_launch: memset failed\n"); return; }
#if MK_MULTI
    for (int p = 0; p < N_PHASES; ++p) { a.ph_lo = p; a.ph_hi = p + 1; hipLaunchKernelGGL(fwd_kernel, dim3(grid), dim3(NTHR), LDS_BYTES, stream, a); }
#else
    a.ph_lo = 0; a.ph_hi = N_PHASES;
    void* kargs[] = {&a};
    hipError_t e = hipLaunchCooperativeKernel((const void*)fwd_kernel, dim3(grid), dim3(NTHR), kargs, LDS_BYTES, stream);
    if (e != hipSuccess) fprintf(stderr, "kernel_launch: cooperative launch failed: %s\n", hipGetErrorString(e));
#endif
}
```

```cpp
#include <hip/hip_runtime.h>
#include <hip/hip_cooperative_groups.h>
#include <cstdio>
namespace cg = cooperative_groups;
namespace pg8 {
#define PG8_LAS __attribute__((address_space(3)))
typedef unsigned short bf16_t;
typedef short bf16x8 __attribute__((ext_vector_type(8)));
typedef float f32x4 __attribute__((ext_vector_type(4)));
typedef unsigned u32x4 __attribute__((ext_vector_type(4)));
constexpr int BM = 256, BK = 64, HALF = 128, HTB = HALF * BK * 2  , STAGE_BYTES = 8 * HTB, NXCD = 8, WGM = 8;

__host__ __device__ __forceinline__ int lds_byte(int r, int c) { const int st = (r >> 4) * 2 + (c >> 5), rr = r & 15, cc = c & 31, ob = rr * 64 + cc * 2; return st * 1024 + (ob ^ (((ob >> 9) & 1) << 5)); }
__host__ __device__ __forceinline__ void stage_rc(int b, int& R, int& C) { const int st = b / 1024, sb = b % 1024, swz = sb ^ (((sb >> 9) & 1) << 5); R = (st >> 1) * 16 + swz / 64; C = (st & 1) * 32 + (swz % 64) / 2; }
__host__ __device__ __forceinline__ int perm32(int rho) { const int n = rho >> 4, i = rho & 15; return 8 * (i >> 2) + 4 * n + (i & 3); }

struct Unit { int pm, pn, koff; };
struct Gemm { const bf16_t* A; const bf16_t* Bt; int M, N, K, ld; };

struct StaticOrder {
    int nM, nN, nwg, G, c;
    __host__ __device__ void init(int M, int N, int G_, int c_) { nM = M / BM; nN = N / BM; nwg = nM * nN; G = G_; c = c_; }
    __host__ __device__ bool next(int i, Unit& u) const {
        const long L = (long)i * G + c; if (L >= nwg) return false;
        int wgid = (int)L; { const int q = nwg / NXCD, r = nwg % NXCD, xcd = wgid % NXCD, off = wgid / NXCD; wgid = (xcd < r ? xcd * (q + 1) : r * (q + 1) + (xcd - r) * q) + off; }
        const int nig = WGM * nN, gid = wgid / nig, fm = gid * WGM, gsz = (nM - fm) < WGM ? (nM - fm) : WGM;
        u.pm = fm + ((wgid % nig) % gsz); u.pn = (wgid % nig) / gsz; u.koff = 0; return true;
    }
    __device__ __forceinline__ void a_ready(const Unit&) const {}
    __device__ __forceinline__ void done(const Unit&) const {}
};
struct SplitOrder {
    int nN, nwg, G, c, pm, klen;
    __host__ __device__ void init(int N, int nsplit, int klen_, int pm_, int G_, int c_) { nN = N / BM; nwg = nN * nsplit; G = G_; c = c_; pm = pm_; klen = klen_; }
    __host__ __device__ bool next(int i, Unit& u) const { const long L = (long)i * G + c; if (L >= nwg) return false; u.pm = pm; u.pn = (int)(L % nN); u.koff = (int)(L / nN) * klen; return true; }
    __device__ __forceinline__ void a_ready(const Unit&) const {}
    __device__ __forceinline__ void done(const Unit&) const {}
};
__device__ __forceinline__ unsigned cvt_pk_bf16(float lo, float hi) { unsigned r; asm volatile("v_cvt_pk_bf16_f32 %0, %1, %2" : "=v"(r) : "v"(lo), "v"(hi)); return r; }
template <class Epi, class Sched, bool STAMP = false>
__device__ __forceinline__ void gemm_phase(PG8_LAS unsigned char* lds, const Gemm g, const Sched& S, const Epi& E, unsigned long long* stamps) {
    int tid_ = threadIdx.x; asm volatile("" : "+v"(tid_)); const int tid = tid_, wid = __builtin_amdgcn_readfirstlane(tid >> 6), lane = tid & 63, wr = wid >> 2, wc = wid & 3, fr = lane & 15, fq = lane >> 4;
    const int K = g.ld, nt = g.K / BK;
    int ts_lo = 0, ts_hi = 0, nts = 0; const unsigned long long rt_entry = STAMP ? (unsigned long long)wall_clock64() : 0ull;
#define PG8_STAMP() do { if (STAMP && wid == 0 && nts < 64) { const unsigned long long _c = (unsigned long long)clock64(); \
        ts_lo = (lane == nts) ? (int)(unsigned)_c : ts_lo; ts_hi = (lane == nts) ? (int)(unsigned)(_c >> 32) : ts_hi; ++nts; } } while (0)
    PG8_STAMP();
    unsigned voffA[2], voffB[2];
#pragma unroll
    for (int i = 0; i < 2; ++i) { int R, C; stage_rc(tid * 16 + i * 8192, R, C); const int Rb = Epi::PERM ? ((R & ~31) + perm32(R & 31)) : R;
        voffA[i] = (unsigned)(R * K + C) * 2u; voffB[i] = (unsigned)(Rb * K + C) * 2u; }
    const size_t kstep = (size_t)(BK * 2);
    const size_t hstep = (size_t)HALF * K * 2;
    const size_t tstep = 2 * hstep;
    const unsigned ldsw = (unsigned)wid * 1024u;
    const int aoff = lds_byte(wr * 64 + fr, fq * 8), boff = lds_byte(wc * 32 + fr, fq * 8);
#define PG8_SA(b, h) (((b) * 2 + (h)) * HTB)
#define PG8_SB(b, h) ((4 + (b) * 2 + (h)) * HTB)
#define PG8_STAGE(bufoff, gbase, voff) do { _Pragma("unroll") for (int _i = 0; _i < 2; ++_i) \
        __builtin_amdgcn_global_load_lds((const unsigned*)((const char*)(gbase) + (voff)[_i]), (PG8_LAS unsigned*)(lds + (bufoff) + ldsw + _i * 8192), 16, 0, 0); } while (0)
#define PG8_LDA(dst, b, h) do { _Pragma("unroll") for (int m = 0; m < 4; ++m) _Pragma("unroll") for (int k = 0; k < 2; ++k) dst[m][k] = *(const PG8_LAS bf16x8*)(lds + PG8_SA(b, h) + aoff + m * 2048 + k * 1024); } while (0)
#define PG8_LDB(dst, b, h) do { _Pragma("unroll") for (int n = 0; n < 2; ++n) _Pragma("unroll") for (int k = 0; k < 2; ++k) dst[n][k] = *(const PG8_LAS bf16x8*)(lds + PG8_SB(b, h) + boff + n * 2048 + k * 1024); } while (0)
#define PG8_MMA(ai, bj, At, Bt) do { __builtin_amdgcn_s_setprio(1); _Pragma("unroll") for (int m = 0; m < 4; ++m) _Pragma("unroll") for (int n = 0; n < 2; ++n) _Pragma("unroll") for (int k = 0; k < 2; ++k) \
        acc[ai][bj][m][n] = __builtin_amdgcn_mfma_f32_16x16x32_bf16(Bt[n][k], At[m][k], acc[ai][bj][m][n], 0, 0, 0); __builtin_amdgcn_s_setprio(0); } while (0)
#define PG8_WAIT_V(n) asm volatile("s_waitcnt vmcnt(" #n ")" ::: "memory")
#define PG8_WAIT_L(n) asm volatile("s_waitcnt lgkmcnt(" #n ")" ::: "memory")
#define PG8_BAR __builtin_amdgcn_s_barrier()
#define PG8_SCHED __builtin_amdgcn_sched_barrier(0)
    Unit cur, nxt; int ui = 0;
    if (!S.next(0, cur)) return;
    f32x4 acc[2][2][4][2];
#pragma unroll
    for (int a = 0; a < 2; ++a)
#pragma unroll
        for (int b = 0; b < 2; ++b)
#pragma unroll
            for (int m = 0; m < 4; ++m)
#pragma unroll
                for (int n = 0; n < 2; ++n) acc[a][b][m][n] = (f32x4){0.f, 0.f, 0.f, 0.f};
    bf16x8 At[4][2], B0[2][2], B1[2][2];
    const char* cA = (const char*)g.A + (size_t)cur.pm * tstep + (size_t)cur.koff * 2; const char* cB = (const char*)g.Bt + (size_t)cur.pn * tstep + (size_t)cur.koff * 2;
    S.a_ready(cur);
    PG8_STAGE(PG8_SB(0, 0), cB, voffB); PG8_STAGE(PG8_SA(0, 0), cA, voffA); PG8_STAGE(PG8_SB(0, 1), cB + hstep, voffB); PG8_STAGE(PG8_SA(0, 1), cA + hstep, voffA);
    if (wr == 1) PG8_BAR;
    PG8_WAIT_V(4); PG8_BAR;
    PG8_STAGE(PG8_SB(1, 0), cB + kstep, voffB); PG8_STAGE(PG8_SA(1, 0), cA + kstep, voffA); PG8_STAGE(PG8_SB(1, 1), cB + hstep + kstep, voffB);
    PG8_WAIT_V(6); PG8_BAR;
    PG8_STAMP();
    for (;;) {
        const bool has_next = S.next(ui + 1, nxt);
        const char* nA = has_next ? (const char*)g.A + (size_t)nxt.pm * tstep + (size_t)nxt.koff * 2 : cA; const char* nB = has_next ? (const char*)g.Bt + (size_t)nxt.pn * tstep + (size_t)nxt.koff * 2 : cB;
        for (int t = 0; t < nt; t += 2) {
            const bool last = (t == nt - 2);
            const char* a1 = cA + (size_t)(t + 1) * kstep;
            const char* a2 = last ? nA : cA + (size_t)(t + 2) * kstep; const char* b2 = last ? nB : cB + (size_t)(t + 2) * kstep;
            const char* a3 = a2 + kstep; const char* b3 = b2 + kstep;
            if (last && has_next) S.a_ready(nxt);
            PG8_LDB(B0, 0, 0); PG8_SCHED; PG8_LDA(At, 0, 0); PG8_STAGE(PG8_SA(1, 1), a1 + hstep, voffA);
            PG8_WAIT_L(8); PG8_BAR; PG8_WAIT_L(0); PG8_MMA(0, 0, At, B0); PG8_BAR; PG8_SCHED;
            PG8_LDB(B1, 0, 1); PG8_STAGE(PG8_SB(0, 0), b2, voffB);
            PG8_BAR; PG8_WAIT_L(0); PG8_MMA(0, 1, At, B1); PG8_BAR;
            PG8_LDA(At, 0, 1); PG8_STAGE(PG8_SA(0, 0), a2, voffA);
            PG8_BAR; PG8_WAIT_L(0); PG8_MMA(1, 0, At, B0); PG8_BAR; PG8_SCHED;
            PG8_STAGE(PG8_SB(0, 1), b2 + hstep, voffB);
            PG8_WAIT_V(6); PG8_BAR; PG8_MMA(1, 1, At, B1); PG8_BAR;
            PG8_LDB(B0, 1, 0); PG8_SCHED; PG8_LDA(At, 1, 0); PG8_STAGE(PG8_SA(0, 1), a2 + hstep, voffA);
            PG8_WAIT_L(8); PG8_BAR; PG8_WAIT_L(0); PG8_MMA(0, 0, At, B0); PG8_BAR; PG8_SCHED;
            PG8_LDB(B1, 1, 1); PG8_STAGE(PG8_SB(1, 0), b3, voffB);
            PG8_BAR; PG8_WAIT_L(0); PG8_MMA(0, 1, At, B1); PG8_BAR;
            PG8_LDA(At, 1, 1); PG8_STAGE(PG8_SA(1, 0), a3, voffA);
            PG8_BAR; PG8_WAIT_L(0); PG8_MMA(1, 0, At, B0); PG8_BAR; PG8_SCHED;
            PG8_STAGE(PG8_SB(1, 1), b3 + hstep, voffB);
            PG8_WAIT_V(6); PG8_BAR; PG8_MMA(1, 1, At, B1); PG8_BAR;
        }
        PG8_STAMP();
        if constexpr (!Epi::AFTER_DRAIN) { E(acc, cur, wr, wc, fr, fq); S.done(cur); }
        PG8_STAMP();
        if (!has_next) break;
#pragma unroll
        for (int a = 0; a < 2; ++a)
#pragma unroll
            for (int b = 0; b < 2; ++b)
#pragma unroll
                for (int m = 0; m < 4; ++m)
#pragma unroll
                    for (int n = 0; n < 2; ++n) acc[a][b][m][n] = (f32x4){0.f, 0.f, 0.f, 0.f};
        cur = nxt; cA = nA; cB = nB; ++ui;
    }
    PG8_WAIT_V(0);
    if (wr == 0) PG8_BAR;
    PG8_BAR;
    if constexpr (Epi::AFTER_DRAIN) { E.fused(acc, cur, wr, wc, fr, fq, lds, wid, lane); S.done(cur); }
    PG8_STAMP();
    if (STAMP && wid == 0) { stamps[lane] = lane < nts ? (((unsigned long long)(unsigned)ts_hi << 32) | (unsigned)ts_lo) : 0ull;
        if (lane == 62) stamps[62] = rt_entry; if (lane == 63) stamps[63] = (unsigned long long)wall_clock64(); }
#undef PG8_STAMP
#undef PG8_SA
#undef PG8_SB
#undef PG8_STAGE
#undef PG8_LDA
#undef PG8_LDB
#undef PG8_MMA
#undef PG8_WAIT_V
#undef PG8_WAIT_L
#undef PG8_BAR
#undef PG8_SCHED
}
}

using pg8::bf16_t; using pg8::bf16x8; using pg8::f32x4; using pg8::u32x4;
typedef unsigned u32x2 __attribute__((ext_vector_type(2)));
#define LDS_WAIT() asm volatile("s_waitcnt lgkmcnt(0)" ::: "memory")
#define LBAR() do { asm volatile("s_waitcnt lgkmcnt(0)" ::: "memory"); __builtin_amdgcn_s_barrier(); asm volatile("" ::: "memory"); } while (0)
#define MFMA16(a, b, c) __builtin_amdgcn_mfma_f32_16x16x32_bf16((a), (b), (c), 0, 0, 0)

constexpr int D = 1024, NB = 8, T = 2048, DEPTH = 4, SB = 128;
constexpr int MP = NB * T;
constexpr int MV = MP + SB;
constexpr int MPAD = 16640;
constexpr int QKVD = 1536, NIN = 3080, NINP = 3328, DFF = 2816, NUP = 5632, NMOD = 6144, MODLD = DEPTH * NMOD;
constexpr int PC_Z = 1536, PC_U = 2048, PC_VB = 2560, PC_BETA = 3072, PC_ALPHA = 3076;
constexpr float EPS = 1e-6f;
constexpr int NWAVES = 8, NTHR = 512;
constexpr int LDS_BYTES = 160 * 1024;

constexpr size_t MiB = 1u << 20;
constexpr size_t WS_W = 1 * MiB;
constexpr size_t WL_IN = 0, WL_OUT = (size_t)NINP * D * 2, WL_UP = WL_OUT + (size_t)D * D * 2, WL_DOWN = WL_UP + (size_t)NUP * D * 2, WL_STRIDE = WL_DOWN + (size_t)D * DFF * 2;
static_assert(WL_STRIDE == 25 * MiB, "weight stride");
constexpr size_t WS_MOD = WS_W + 4 * WL_STRIDE;
constexpr size_t WS_XR = WS_MOD + 13 * MiB;
constexpr size_t WS_AB = WS_XR + 65 * MiB;
constexpr size_t WS_BIG = WS_AB + 33 * MiB;
constexpr size_t WS_OBUF = WS_BIG + 106 * MiB;
constexpr size_t WS_RAW = WS_BIG + 140 * MiB;
static_assert((size_t)(MP / 64) * 4 * NUP * 4 <= 39 * MiB, "raw");
constexpr size_t WS_ACT = WS_BIG + 179 * MiB;
constexpr size_t WS_WMODT = WS_ACT;
constexpr size_t WS_CACT = WS_ACT + 48 * MiB;
constexpr size_t WS_PS = WS_ACT + 90 * MiB;
constexpr size_t WS_UPS = WS_BIG + 163 * MiB;
constexpr size_t WS_UPS_OLD = WS_PS + 7 * MiB;
constexpr size_t WS_RP = WS_UPS_OLD + 12 * MiB;
constexpr size_t WS_BA = WS_RP + 6 * MiB;
constexpr size_t WS_END = WS_BA + 1 * MiB;
constexpr int NIN_G = 3072;
static_assert((size_t)4 * SB * NIN_G * 4 <= 7 * MiB && (size_t)4 * SB * NUP * 4 <= 12 * MiB && (size_t)11 * SB * D * 4 <= 6 * MiB && (size_t)MV * 8 * 4 <= 1 * MiB, "ws map 3");
static_assert((size_t)136 * MODLD * 4 <= 13 * MiB && (size_t)MPAD * D * 4 <= 65 * MiB && (size_t)MPAD * D * 2 <= 33 * MiB, "ws map");
static_assert((size_t)MPAD * NINP * 2 <= 106 * MiB && (size_t)MPAD * NUP * 2 <= 179 * MiB && (size_t)MPAD * DFF * 2 <= 90 * MiB, "ws map 2");
constexpr int DR_NW = 0, DR_QG = 17408, DR_QK = 34816, DR_KDT = 44032, DR_UT = 62464, DR_EG = 80896, DR_STRIDE = 81152;
static_assert((size_t)1024 * DR_STRIDE <= 90 * MiB, "dr");

constexpr size_t O_Y = 0, O_DP = 16908288, O_DS = 19005440, O_QP = 52559872, O_QS = 52707328, O_FP = 55066624, O_FS = 55427072, O_SV = 61194240, O_END = 61456384;

__device__ __forceinline__ float bf2f(unsigned short b) { return __uint_as_float(((unsigned)b) << 16); }
__device__ __forceinline__ unsigned f2bf(float f) { return (unsigned)__builtin_bit_cast(unsigned short, (__bf16)f); }
typedef __bf16 bf16v2_t __attribute__((ext_vector_type(2)));
__device__ __forceinline__ unsigned pk2(float lo, float hi) { bf16v2_t v; v.x = (__bf16)lo; v.y = (__bf16)hi; return __builtin_bit_cast(unsigned, v); }
__device__ __forceinline__ float lo_f(unsigned w) { return __uint_as_float(w << 16); }
__device__ __forceinline__ float hi_f(unsigned w) { return __uint_as_float(w & 0xffff0000u); }
__device__ __forceinline__ float silu_f(float x) { return x * __builtin_amdgcn_rcpf(1.f + __expf(-x)); }
__device__ __forceinline__ float gelu_f(float x) { const float y = 0.7978845608028654f * (x + 0.044715f * x * x * x); const float th = 1.f - 2.f * __builtin_amdgcn_rcpf(__expf(2.f * y) + 1.f); return 0.5f * x * (1.f + th); }
__device__ __forceinline__ float softplus_f(float x) { return x > 20.f ? x : log1pf(__expf(x)); }
__device__ __forceinline__ float wave_sum(float v) {
#pragma unroll
    for (int o = 1; o < 64; o <<= 1) v += __shfl_xor(v, o);
    return v;
}
__device__ __forceinline__ float sum16(float v) { v += __shfl_xor(v, 1); v += __shfl_xor(v, 2); v += __shfl_xor(v, 4); v += __shfl_xor(v, 8); return v; }
__device__ __forceinline__ void unpack8(const u32x4 v, float (&x)[8]) { x[0] = lo_f(v.x); x[1] = hi_f(v.x); x[2] = lo_f(v.y); x[3] = hi_f(v.y); x[4] = lo_f(v.z); x[5] = hi_f(v.z); x[6] = lo_f(v.w); x[7] = hi_f(v.w); }
__device__ __forceinline__ u32x4 pack8(const float (&x)[8]) { u32x4 o; o.x = pk2(x[0], x[1]); o.y = pk2(x[2], x[3]); o.z = pk2(x[4], x[5]); o.w = pk2(x[6], x[7]); return o; }
__device__ __forceinline__ int mod_row(int m) { return m < MP ? (m >> 11) : (8 + m - MP); }

struct EpiMod {
    static constexpr bool PERM = false, AFTER_DRAIN = false;
    float* C; const float* bias;
    __device__ __forceinline__ void operator()(const f32x4 (&acc)[2][2][4][2], const pg8::Unit& u, int wr, int wc, int fr, int fq) const {
        const int row0 = u.pm * 256 + wr * 64 + fr, col0 = u.pn * 256 + wc * 32 + 4 * fq;
#pragma unroll
        for (int ai = 0; ai < 2; ++ai)
#pragma unroll
            for (int m = 0; m < 4; ++m) { const int row = row0 + ai * 128 + m * 16;
                if (row < 136) {
#pragma unroll
                    for (int bj = 0; bj < 2; ++bj)
#pragma unroll
                        for (int n = 0; n < 2; ++n) { const int col = col0 + bj * 128 + n * 16; *(f32x4*)(C + (size_t)row * MODLD + col) = acc[ai][bj][m][n] + *(const f32x4*)(bias + col); } } }
    }
};
struct EpiBf {
    static constexpr bool PERM = true, AFTER_DRAIN = false;
    bf16_t* O; int ldc;
    __device__ __forceinline__ void operator()(const f32x4 (&acc)[2][2][4][2], const pg8::Unit& u, int wr, int wc, int fr, int fq) const {
        const int row0 = u.pm * 256 + wr * 64 + fr, col0 = u.pn * 256 + wc * 32 + 8 * fq;
#pragma unroll
        for (int ai = 0; ai < 2; ++ai)
#pragma unroll
            for (int m = 0; m < 4; ++m) { bf16_t* rowp = O + (size_t)(row0 + ai * 128 + m * 16) * ldc + col0;
#pragma unroll
                for (int bj = 0; bj < 2; ++bj) { const f32x4 v0 = acc[ai][bj][m][0], v1 = acc[ai][bj][m][1];
                    u32x4 w; w.x = pg8::cvt_pk_bf16(v0[0], v0[1]); w.y = pg8::cvt_pk_bf16(v0[2], v0[3]); w.z = pg8::cvt_pk_bf16(v1[0], v1[1]); w.w = pg8::cvt_pk_bf16(v1[2], v1[3]);
                    *(u32x4*)(rowp + bj * 128) = w; } }
    }
};
struct EpiRes {
    static constexpr bool PERM = false, AFTER_DRAIN = false;
    float* X; const float* gate; int gs;
    __device__ __forceinline__ void operator()(const f32x4 (&acc)[2][2][4][2], const pg8::Unit& u, int wr, int wc, int fr, int fq) const {
        const int row0 = u.pm * 256 + wr * 64 + fr, col0 = u.pn * 256 + wc * 32 + 4 * fq;
        const float* gp = gate + (size_t)mod_row(u.pm * 256) * gs;
        f32x4 g[2][2];
#pragma unroll
        for (int bj = 0; bj < 2; ++bj)
#pragma unroll
            for (int n = 0; n < 2; ++n) g[bj][n] = *(const f32x4*)(gp + col0 + bj * 128 + n * 16);
        f32x4 xn[2][2], xm[2][2];
        { const float* xp = X + (size_t)row0 * D; const float* xq = X + (size_t)(row0 + 16) * D;
#pragma unroll
          for (int bj = 0; bj < 2; ++bj)
#pragma unroll
              for (int n = 0; n < 2; ++n) { xn[bj][n] = *(const f32x4*)(xp + col0 + bj * 128 + n * 16); xm[bj][n] = *(const f32x4*)(xq + col0 + bj * 128 + n * 16); } }
#pragma unroll
        for (int gi = 0; gi < 8; ++gi) { const int ai = gi >> 2, m = gi & 3; const int row = row0 + ai * 128 + m * 16;
            f32x4 xc[2][2];
#pragma unroll
            for (int bj = 0; bj < 2; ++bj)
#pragma unroll
                for (int n = 0; n < 2; ++n) { xc[bj][n] = xn[bj][n]; xn[bj][n] = xm[bj][n]; }
            if (gi + 2 < 8) { const int rown = row0 + ((gi + 2) >> 2) * 128 + ((gi + 2) & 3) * 16; const float* xq = X + (size_t)rown * D;
#pragma unroll
                for (int bj = 0; bj < 2; ++bj)
#pragma unroll
                    for (int n = 0; n < 2; ++n) xm[bj][n] = *(const f32x4*)(xq + col0 + bj * 128 + n * 16); }
            float* xp = X + (size_t)row * D;
#pragma unroll
            for (int bj = 0; bj < 2; ++bj)
#pragma unroll
                for (int n = 0; n < 2; ++n) *(f32x4*)(xp + col0 + bj * 128 + n * 16) = xc[bj][n] + g[bj][n] * acc[ai][bj][m][n]; }
    }
};

struct EpiPart {
    static constexpr bool PERM = false, AFTER_DRAIN = false;
    float* C; int N, klen;
    __device__ __forceinline__ void operator()(const f32x4 (&acc)[2][2][4][2], const pg8::Unit& u, int wr, int wc, int fr, int fq) const {
        const int lrow0 = wr * 64 + fr, col0 = u.pn * 256 + wc * 32 + 4 * fq;
        float* base = C + (size_t)(u.koff / klen) * SB * N;
#pragma unroll
        for (int m = 0; m < 4; ++m) { float* rp = base + (size_t)(lrow0 + m * 16) * N + col0;
#pragma unroll
            for (int bj = 0; bj < 2; ++bj)
#pragma unroll
                for (int n = 0; n < 2; ++n) *(f32x4*)(rp + bj * 128 + n * 16) = acc[0][bj][m][n]; }
    }
};

#define DPP_F(oldv, srcv, ctrl) __int_as_float(__builtin_amdgcn_update_dpp(__float_as_int(oldv), __float_as_int(srcv), (ctrl), 0xF, 0xF, false))
struct EpiUpCG {
    static constexpr bool PERM = true, AFTER_DRAIN = false;
    bf16_t* ACTp; float* RAW; const float* cwf; const float* cbf;
    __device__ __forceinline__ void operator()(const f32x4 (&acc)[2][2][4][2], const pg8::Unit& u, int wr, int wc, int fr, int fq) const {
        const int cc0 = wc * 32 + 8 * fq, ca0 = 128 * u.pn + cc0;
        if (u.pm == MP / 256) {
            float* rp = RAW + (WS_UPS - WS_RAW) / 4 + (size_t)(wr * 64 + fr) * NUP + 256 * u.pn + cc0;
#pragma unroll
            for (int m = 0; m < 4; ++m) {
#pragma unroll
                for (int bj = 0; bj < 2; ++bj) { *(f32x4*)(rp + (size_t)m * 16 * NUP + bj * 128) = acc[0][bj][m][0]; *(f32x4*)(rp + (size_t)m * 16 * NUP + bj * 128 + 4) = acc[0][bj][m][1]; } }
            return; }
#pragma unroll
        for (int n = 0; n < 2; ++n) {
            const int ca = ca0 + 4 * n;
            const f32x4 w0a = *(const f32x4*)(cwf + ca), w1a = *(const f32x4*)(cwf + NUP + ca), w2a = *(const f32x4*)(cwf + 2 * NUP + ca), ba = *(const f32x4*)(cbf + ca);
            const f32x4 w0g = *(const f32x4*)(cwf + DFF + ca), w1g = *(const f32x4*)(cwf + NUP + DFF + ca), w2g = *(const f32x4*)(cwf + 2 * NUP + DFF + ca), bg = *(const f32x4*)(cbf + DFF + ca);
#pragma unroll
            for (int ai = 0; ai < 2; ++ai) {
                const int slab = u.pm * 4 + ai * 2 + wr;
                float* rawp = RAW + (size_t)slab * 4 * NUP + 256 * u.pn + cc0 + 4 * n;
#pragma unroll
                for (int m = 0; m < 4; ++m) {
                    const f32x4 xa = acc[ai][0][m][n], xg = acc[ai][1][m][n];
                    const f32x4 pa = acc[ai][0][m > 0 ? m - 1 : 0][n], pg = acc[ai][1][m > 0 ? m - 1 : 0][n];
                    float o[4];
#pragma unroll
                    for (int j = 0; j < 4; ++j) {
                        const float a1 = DPP_F(DPP_F(0.f, pa[j], 0x121), xa[j], 0x111), a2 = DPP_F(DPP_F(0.f, pa[j], 0x122), xa[j], 0x112);
                        const float g1 = DPP_F(DPP_F(0.f, pg[j], 0x121), xg[j], 0x111), g2 = DPP_F(DPP_F(0.f, pg[j], 0x122), xg[j], 0x112);
                        const float va = w0a[j] * a2 + w1a[j] * a1 + w2a[j] * xa[j] + ba[j];
                        const float vg = w0g[j] * g2 + w1g[j] * g1 + w2g[j] * xg[j] + bg[j];
                        o[j] = silu_f(va) * vg; }
                    const int row = u.pm * 256 + ai * 128 + wr * 64 + m * 16 + fr;
                    if (!(m == 0 && fr < 2)) { u32x2 w; w.x = pg8::cvt_pk_bf16(o[0], o[1]); w.y = pg8::cvt_pk_bf16(o[2], o[3]); *(u32x2*)(ACTp + (size_t)row * DFF + ca) = w; }
                    if (m == 0 && fr < 2) { *(f32x4*)(rawp + (size_t)fr * NUP) = xa; *(f32x4*)(rawp + (size_t)fr * NUP + 128) = xg; }
                    if (m == 3 && fr >= 14) { *(f32x4*)(rawp + (size_t)(fr - 12) * NUP) = xa; *(f32x4*)(rawp + (size_t)(fr - 12) * NUP + 128) = xg; }
                }
            }
        }
    }
};

__device__ __forceinline__ void tr_item(const float* W, int ldw, int K, int nblk, bf16_t* WT, float* scr, int item, int lane) {
    const int kb = item / nblk, nb = item % nblk, k0 = 64 * kb, n0 = 32 * nb;
#pragma unroll 8
    for (int i = 0; i < 32; ++i) { const int kk = 2 * i + (lane >> 5); scr[kk * 33 + (lane & 31)] = W[(size_t)(k0 + kk) * ldw + n0 + (lane & 31)]; }
    LDS_WAIT();
    const int c = lane & 7;
#pragma unroll
    for (int j = 0; j < 4; ++j) { const int n = (lane >> 3) + 8 * j; const float* s = scr + (8 * c) * 33 + n;
        u32x4 o; o.x = pk2(s[0 * 33], s[1 * 33]); o.y = pk2(s[2 * 33], s[3 * 33]); o.z = pk2(s[4 * 33], s[5 * 33]); o.w = pk2(s[6 * 33], s[7 * 33]);
        *(u32x4*)(WT + (size_t)(n0 + n) * K + k0 + 8 * c) = o; }
    LDS_WAIT();
}
constexpr int CV_PER_LAYER = 1024 + 256 + 256 + 264 + 512 + 2816 + 1408 + 3072;

__device__ __forceinline__ void phase_convert(unsigned char* lds, unsigned char* ws, const float* w_in, const float* w_out, const float* w_up, const float* w_down, const float* w_mod,
                                              const float* c_prompt, const float* c_sample, int gw, int ngw, int wave, int lane) {
    float* scr = (float*)(lds + wave * 16384);
    for (int it = gw; it < DEPTH * CV_PER_LAYER; it += ngw) {
        const int l = it / CV_PER_LAYER; int r = it % CV_PER_LAYER;
        const float* win = w_in + (size_t)l * D * NIN;
        bf16_t* wl = (bf16_t*)(ws + WS_W + l * WL_STRIDE);
        bf16_t* wint = wl;
        if (r < 1024) { tr_item(win, NIN, D, 64, wint, scr, r, lane); continue; } r -= 1024;
        if (r < 256) { tr_item(win + 2056, NIN, D, 16, wint + (size_t)PC_U * D, scr, r, lane); continue; } r -= 256;
        if (r < 256) { tr_item(win + 2568, NIN, D, 16, wint + (size_t)PC_VB * D, scr, r, lane); continue; } r -= 256;
        if (r < 264) {
            if (r < 16) { const int k = 64 * r + lane;
#pragma unroll
                for (int n = 0; n < 8; ++n) wint[(size_t)(PC_BETA + n) * D + k] = (bf16_t)f2bf(win[(size_t)k * NIN + 2048 + n]); }
            else { u32x4* z = (u32x4*)(wint + (size_t)(NIN + (r - 16)) * D); const u32x4 zero = {0u, 0u, 0u, 0u}; z[lane] = zero; z[lane + 64] = zero; }
            continue; } r -= 264;
        if (r < 512) { tr_item(w_out + (size_t)l * D * D, D, D, 32, (bf16_t*)((unsigned char*)wl + WL_OUT), scr, r, lane); continue; } r -= 512;
        if (r < 2816) {
            const int kb = r / 176, nb = r % 176, c0 = 32 * nb, hf = c0 >= DFF ? 1 : 0, cl = c0 - hf * DFF;
            const int drow = 256 * (cl >> 7) + 128 * hf + (cl & 127);
            tr_item(w_up + (size_t)l * D * NUP + c0, NUP, D, 1, (bf16_t*)((unsigned char*)wl + WL_UP) + (size_t)drow * D, scr, kb, lane); continue; } r -= 2816;
        if (r < 1408) { tr_item(w_down + (size_t)l * DFF * D, D, DFF, 32, (bf16_t*)((unsigned char*)wl + WL_DOWN), scr, r, lane); continue; } r -= 1408;
        tr_item(w_mod + (size_t)l * D * NMOD, NMOD, D, 192, (bf16_t*)(ws + WS_WMODT) + (size_t)l * NMOD * D, scr, r, lane);
    }
    bf16_t* cact = (bf16_t*)(ws + WS_CACT);
    for (int idx = gw * 64 + lane; idx < 256 * 128; idx += ngw * 64) {
        const int row = idx >> 7, c8 = (idx & 127) * 8; u32x4 o = {0u, 0u, 0u, 0u};
        if (row < 136) { const float* src = row < 8 ? c_prompt + (size_t)row * D + c8 : c_sample + (size_t)(row - 8) * D + c8;
            const f32x4 a = *(const f32x4*)src, b = *(const f32x4*)(src + 4);
            o.x = pk2(silu_f(a.x), silu_f(a.y)); o.y = pk2(silu_f(a.z), silu_f(a.w)); o.z = pk2(silu_f(b.x), silu_f(b.y)); o.w = pk2(silu_f(b.z), silu_f(b.w)); }
        *(u32x4*)(cact + (size_t)row * D + c8) = o;
    }
}

__device__ __forceinline__ void phase_ln(const float* xa, const float* xb, const float* nw, const float* sh, const float* sc, bf16_t* out, float* xr_copy,
                                         const float* part, int nsplit, const float* pgate, float* xw, const f32x4* tba, float* BA, int gw, int ngw, int lane) {
    f32x4 vnx[4];
#pragma unroll
    for (int j = 0; j < 4; ++j) vnx[j] = (f32x4){0.f, 0.f, 0.f, 0.f};
    f32x4 nwv[4], scn[4], shn[4];
#pragma unroll
    for (int j = 0; j < 4; ++j) { nwv[j] = *(const f32x4*)(nw + 4 * lane + 256 * j); scn[j] = (f32x4){0.f, 0.f, 0.f, 0.f}; shn[j] = (f32x4){0.f, 0.f, 0.f, 0.f}; }
    if (gw < MV) { const f32x4* xr0 = (const f32x4*)(gw < MP ? xa + (size_t)gw * D : xb + (size_t)(gw - MP) * D) + lane; const size_t mo = (size_t)mod_row(gw) * MODLD + 4 * lane;
#pragma unroll
        for (int j = 0; j < 4; ++j) { vnx[j] = xr0[64 * j]; scn[j] = *(const f32x4*)(sc + mo + 256 * j); shn[j] = *(const f32x4*)(sh + mo + 256 * j); } }
    for (int m = gw; m < MPAD; m += ngw) {
        u32x2* o8 = (u32x2*)(out + (size_t)m * D) + lane;
        if (m >= MV) { const u32x2 z = {0u, 0u};
#pragma unroll
            for (int j = 0; j < 4; ++j) o8[64 * j] = z;
            continue; }
        const int mr = mod_row(m);
        f32x4 v[4]; float s = 0.f;
        f32x4 scc[4], shc[4];
#pragma unroll
        for (int j = 0; j < 4; ++j) { v[j] = vnx[j]; scc[j] = scn[j]; shc[j] = shn[j]; }
        { const int mn = m + ngw;
          if (mn < MV) { const f32x4* xrn = (const f32x4*)(mn < MP ? xa + (size_t)mn * D : xb + (size_t)(mn - MP) * D) + lane; const size_t mo = (size_t)mod_row(mn) * MODLD + 4 * lane;
#pragma unroll
              for (int j = 0; j < 4; ++j) { vnx[j] = xrn[64 * j]; scn[j] = *(const f32x4*)(sc + mo + 256 * j); shn[j] = *(const f32x4*)(sh + mo + 256 * j); } } }
        if (m >= MP && nsplit > 0) {
#pragma unroll
            for (int j = 0; j < 4; ++j) { const int c = 4 * lane + 256 * j; f32x4 a = {0.f, 0.f, 0.f, 0.f};
                { f32x4 pt[11];
#pragma unroll
                  for (int ks = 0; ks < 11; ++ks) { if (ks < nsplit) pt[ks] = *(const f32x4*)(part + ((size_t)ks * SB + (m - MP)) * D + c); else pt[ks] = (f32x4){0.f, 0.f, 0.f, 0.f}; }
#pragma unroll
                  for (int ks = 0; ks < 11; ++ks) a += pt[ks]; }
                v[j] += a * *(const f32x4*)(pgate + (size_t)mr * MODLD + c);
                *(f32x4*)(xw + (size_t)m * D + c) = v[j]; } }
#pragma unroll
        for (int j = 0; j < 4; ++j) s += (v[j].x * v[j].x + v[j].y * v[j].y) + (v[j].z * v[j].z + v[j].w * v[j].w);
        s = wave_sum(s);
        const float rstd = __builtin_amdgcn_rsqf(s * (1.f / D) + EPS);
        f32x4 d0 = {0.f, 0.f, 0.f, 0.f}, d1 = {0.f, 0.f, 0.f, 0.f};
#pragma unroll
        for (int j = 0; j < 4; ++j) { const int c = 4 * lane + 256 * j;
            const f32x4 w = nwv[j], s1 = scc[j], s0 = shc[j];
            const f32x4 h = v[j] * rstd * w * (s1 + 1.f) + s0;
            u32x2 o; o.x = pk2(h.x, h.y); o.y = pk2(h.z, h.w); o8[64 * j] = o;
            if (xr_copy) *((f32x4*)(xr_copy + (size_t)m * D) + lane + 64 * j) = v[j];
            if (tba) {
#pragma unroll
                for (int e = 0; e < 4; ++e) { const float he = h[e]; d0 += tba[((j * 4 + e) * 2 + 0) * 64 + lane] * he; d1 += tba[((j * 4 + e) * 2 + 1) * 64 + lane] * he; } } }
        if (tba) {
            d0.x = wave_sum(d0.x); d0.y = wave_sum(d0.y); d0.z = wave_sum(d0.z); d0.w = wave_sum(d0.w);
            d1.x = wave_sum(d1.x); d1.y = wave_sum(d1.y); d1.z = wave_sum(d1.z); d1.w = wave_sum(d1.w);
            if (lane == 0) { *(f32x4*)(BA + (size_t)m * 8) = d0; *(f32x4*)(BA + (size_t)m * 8 + 4) = d1; } }
    }
}
__device__ __forceinline__ void fill_tba(float* T, const float* win, int tid) {
    for (int idx = tid; idx < 8192; idx += NTHR) { const int i = idx & 3, ln = (idx >> 2) & 63, half = (idx >> 8) & 1, e = (idx >> 9) & 3, j = idx >> 11;
        T[idx] = win[(size_t)(4 * ln + 256 * j + e) * NIN + 2048 + 4 * half + i]; }
    __syncthreads();
}
__device__ __forceinline__ void phase_final(const float* X, const float* fw, float* out, const float* part, int nsplit, const float* pgate, int gw, int ngw, int lane) {
    for (int m = gw; m < MV; m += ngw) {
        const f32x4* xr = (const f32x4*)(X + (size_t)m * D) + lane;
        f32x4 v[4]; float s = 0.f;
#pragma unroll
        for (int j = 0; j < 4; ++j) v[j] = xr[64 * j];
        if (m >= MP) { const int mr = mod_row(m);
#pragma unroll
            for (int j = 0; j < 4; ++j) { const int c = 4 * lane + 256 * j; f32x4 a = {0.f, 0.f, 0.f, 0.f};
                { f32x4 pt[11];
#pragma unroll
                  for (int ks = 0; ks < 11; ++ks) { if (ks < nsplit) pt[ks] = *(const f32x4*)(part + ((size_t)ks * SB + (m - MP)) * D + c); else pt[ks] = (f32x4){0.f, 0.f, 0.f, 0.f}; }
#pragma unroll
                  for (int ks = 0; ks < 11; ++ks) a += pt[ks]; }
                v[j] += a * *(const f32x4*)(pgate + (size_t)mr * MODLD + c); } }
#pragma unroll
        for (int j = 0; j < 4; ++j) s += (v[j].x * v[j].x + v[j].y * v[j].y) + (v[j].z * v[j].z + v[j].w * v[j].w);
        s = wave_sum(s);
        const float rstd = __builtin_amdgcn_rsqf(s * (1.f / D) + EPS);
#pragma unroll
        for (int j = 0; j < 4; ++j) { const int c = 4 * lane + 256 * j; const f32x4 w = *(const f32x4*)(fw + c); *((f32x4*)(out + (size_t)m * D) + lane + 64 * j) = v[j] * rstd * w; }
    }
}

template <int I> struct FwdSub {
    static __device__ __forceinline__ void run(float (&sol)[64], const float* sLv, const float (&Lc)[64]) {
        float Ln[64];
#pragma unroll
        for (int q = 0; q < 16; ++q) if (I + 1 < 64 && 4 * q < I + 1) { const f32x4 t4 = *(const f32x4*)(sLv + (I + 1) * 68 + 4 * q); Ln[4 * q] = t4.x; Ln[4 * q + 1] = t4.y; Ln[4 * q + 2] = t4.z; Ln[4 * q + 3] = t4.w; }
        float a0 = sol[I], a1 = 0.f;
#pragma unroll
        for (int j = 0; j < I; ++j) { if (j & 1) a1 -= Lc[j] * sol[j]; else a0 -= Lc[j] * sol[j]; }
        sol[I] = a0 + a1;
        FwdSub<I + 1>::run(sol, sLv, Ln);
    }
};
template <> struct FwdSub<64> { static __device__ __forceinline__ void run(float (&)[64], const float*, const float (&)[64]) {} };

struct PrepIn { float braw, araw; };
__device__ __forceinline__ void prep_fetch(PrepIn& I, const bf16_t* P, const float* BA, int b, int ci, int h, int tid) {
    const size_t m0 = (size_t)b * T + (size_t)ci * 64;
    I.braw = 0.f; I.araw = 0.f;
    if (tid < 64) { I.braw = BA[(m0 + tid) * 8 + h]; I.araw = BA[(m0 + tid) * 8 + 4 + h]; }
    const int grp = tid & 15, run = (tid >> 4) & 7, tensor = tid >> 7;
    const int ch = tensor * 512 + h * 128 + grp * 8, tbase = run * 8;
    (void)ch; (void)tbase;
}
__device__ __forceinline__ void prep_item(unsigned char* lds, const bf16_t* P, const float* BA, const float* cw, float alog, float dtb, unsigned char* dr, float* qkvconv_out, int b, int ci, int h, int tid,
                                          const PrepIn& cur, PrepIn& nxt, bool has_next, int nb, int nci, int nh) {
    asm volatile("" : "+v"(tid));
    bf16_t* sKn = (bf16_t*)lds; bf16_t* sKB = (bf16_t*)(lds + 17408); bf16_t* sQ = (bf16_t*)(lds + 34816);
    float* sRhs = (float*)(lds + 52224); float* sL = (float*)(lds + 117760); float* sBeta = (float*)(lds + 135168); float* sGc = (float*)(lds + 135424);
    const int lane = tid & 63, wid = __builtin_amdgcn_readfirstlane(tid >> 6);
    const size_t m0 = (size_t)b * T + (size_t)ci * 64;
    if (tid < 64) {
        const float braw = cur.braw, araw = cur.araw;
        const float beta = __builtin_amdgcn_rcpf(1.f + __expf(-braw));
        float g = -__expf(alog) * softplus_f(araw + dtb);
#pragma unroll
        for (int off = 1; off < 64; off <<= 1) { const float v = __shfl_up(g, off); if (lane >= off) g += v; }
        sBeta[tid] = beta; sGc[tid] = g;
    }
    LBAR();
    const float gl = sGc[63];
    if (tid < 384) {
        const int grp = tid & 15, run = (tid >> 4) & 7, tensor = __builtin_amdgcn_readfirstlane(tid >> 7);
        const int ch = tensor * 512 + h * 128 + grp * 8, tbase = run * 8;
        u32x4 xr[11];
#pragma unroll
        for (int q = 0; q < 11; ++q) { const int tt = tbase - 3 + q; if (ci * 64 + tt >= 0) xr[q] = *(const u32x4*)(P + (size_t)((long)m0 + tt) * NINP + ch); else xr[q] = (u32x4){0u, 0u, 0u, 0u}; }
        f32x4 wa[4], wb[4];
#pragma unroll
        for (int j = 0; j < 4; ++j) { wa[j] = *(const f32x4*)(cw + j * QKVD + ch); wb[j] = *(const f32x4*)(cw + j * QKVD + ch + 4); }
#pragma unroll
        for (int q2 = 0; q2 < 8; ++q2) {
            const int t = tbase + q2;
            float y[8];
#pragma unroll
            for (int e = 0; e < 8; ++e) y[e] = 0.f;
#pragma unroll
            for (int j = 0; j < 4; ++j) {
                float x[8]; unpack8(xr[q2 + j], x);
                y[0] += wa[j].x * x[0]; y[1] += wa[j].y * x[1]; y[2] += wa[j].z * x[2]; y[3] += wa[j].w * x[3];
                y[4] += wb[j].x * x[4]; y[5] += wb[j].y * x[5]; y[6] += wb[j].z * x[6]; y[7] += wb[j].w * x[7];
            }
            if (qkvconv_out != nullptr && t >= 61) { float x[8]; unpack8(xr[q2 + 3], x); float* o = qkvconv_out + (size_t)(t - 61) * QKVD + ch;
                *(f32x4*)o = (f32x4){x[0], x[1], x[2], x[3]}; *(f32x4*)(o + 4) = (f32x4){x[4], x[5], x[6], x[7]}; }
            float ss = 0.f;
#pragma unroll
            for (int e = 0; e < 8; ++e) { y[e] = silu_f(y[e]); ss += y[e] * y[e]; }
            ss = sum16(ss);
            const float bt = sBeta[t], gc = sGc[t];
            if (tensor == 0) {
                const float rn = __builtin_amdgcn_rsqf(ss + EPS) * 0.08838834764831845f;
#pragma unroll
                for (int e = 0; e < 8; ++e) y[e] *= rn;
                *(u32x4*)(sQ + t * 136 + grp * 8) = pack8(y);
                const float eg = __expf(gc);
#pragma unroll
                for (int e = 0; e < 8; ++e) y[e] *= eg;
                *(u32x4*)(dr + DR_QG + (t * 136 + grp * 8) * 2) = pack8(y);
            } else if (tensor == 1) {
                const float rn = __builtin_amdgcn_rsqf(ss + EPS);
#pragma unroll
                for (int e = 0; e < 8; ++e) y[e] *= rn;
                *(u32x4*)(sKn + t * 136 + grp * 8) = pack8(y);
                const float kd = __expf(gl - gc);
                bf16_t* kdt = (bf16_t*)(dr + DR_KDT) + grp * 8 * 72 + tbase;
#pragma unroll
                for (int e = 0; e < 8; ++e) kdt[e * 72 + q2] = (bf16_t)f2bf(y[e] * kd);
#pragma unroll
                for (int e = 0; e < 8; ++e) y[e] *= bt;
                *(u32x4*)(sKB + t * 136 + grp * 8) = pack8(y);
                const float eg = __expf(gc);
                float* r = sRhs + t * 256 + 128 + grp * 8;
                *(f32x4*)r = (f32x4){y[0] * eg, y[1] * eg, y[2] * eg, y[3] * eg}; *(f32x4*)(r + 4) = (f32x4){y[4] * eg, y[5] * eg, y[6] * eg, y[7] * eg};
            } else {
                float* r = sRhs + t * 256 + grp * 8;
                *(f32x4*)r = (f32x4){y[0] * bt, y[1] * bt, y[2] * bt, y[3] * bt}; *(f32x4*)(r + 4) = (f32x4){y[4] * bt, y[5] * bt, y[6] * bt, y[7] * bt};
            }
            __builtin_amdgcn_sched_barrier(0);
        }
    }
    LBAR();
    if (has_next) prep_fetch(nxt, P, BA, nb, nci, nh, tid);
    {
        const int rt = wid & 3, isqk = wid >> 2, fr = lane & 15, fq = lane >> 4;
        const bf16_t* asrc = isqk ? sQ : sKB;
        bf16x8 a[4];
#pragma unroll
        for (int ks = 0; ks < 4; ++ks) a[ks] = *(const bf16x8*)(asrc + (16 * rt + fr) * 136 + ks * 32 + fq * 8);
        bf16_t* qkg = (bf16_t*)(dr + DR_QK);
#pragma unroll
        for (int ct = 0; ct < 4; ++ct) {
            f32x4 acc = {0.f, 0.f, 0.f, 0.f};
            if (ct <= rt) {
#pragma unroll
                for (int ks = 0; ks < 4; ++ks) { const bf16x8 bb = *(const bf16x8*)(sKn + (16 * ct + fr) * 136 + ks * 32 + fq * 8); acc = MFMA16(a[ks], bb, acc); }
            }
            const int j = 16 * ct + fr; const float gj = sGc[j];
#pragma unroll
            for (int jj = 0; jj < 4; ++jj) { const int i = 16 * rt + 4 * fq + jj; const float d = __expf(fminf(sGc[i] - gj, 0.f));
                if (!isqk) { if (ct <= rt) sL[i * 68 + j] = (j < i) ? acc[jj] * d : 0.f; }
                else { const float v = (j <= i) ? acc[jj] * d : 0.f; qkg[i * 72 + j] = (bf16_t)f2bf(v); } }
        }
    }
    LBAR();
    if (wid < 4) {
        const int col = wid * 64 + lane;
        int vz; asm volatile("v_mov_b32 %0, 0" : "=v"(vz));
        const float* sLv = sL + vz;
        float sol[64];
#pragma unroll
        for (int i = 0; i < 64; ++i) sol[i] = sRhs[i * 256 + col];
        float Lc[64];
        { const f32x4 t4 = *(const f32x4*)(sLv + 1 * 68); Lc[0] = t4.x; Lc[1] = t4.y; Lc[2] = t4.z; Lc[3] = t4.w; }
        FwdSub<1>::run(sol, sLv, Lc);
        if (wid < 2) { u32x4* dst = (u32x4*)(dr + DR_UT + col * 144);
#pragma unroll
            for (int q = 0; q < 8; ++q) { u32x4 o; o.x = pk2(sol[8 * q], sol[8 * q + 1]); o.y = pk2(sol[8 * q + 2], sol[8 * q + 3]); o.z = pk2(sol[8 * q + 4], sol[8 * q + 5]); o.w = pk2(sol[8 * q + 6], sol[8 * q + 7]); dst[q] = o; } }
        else { bf16_t* nw = (bf16_t*)(dr + DR_NW); const int k = col - 128;
#pragma unroll
            for (int i = 0; i < 64; ++i) nw[i * 136 + k] = (bf16_t)f2bf(-sol[i]); }
    }
    if (tid == 0) *(float*)(dr + DR_EG) = __expf(gl);
    LBAR();
}

__device__ __forceinline__ void sgu_item(unsigned char* lds, const bf16_t* P, const float* Wl, const float* bl, const float* nl, bf16_t* MIX, int b, int n, int h, int tid) {
    asm volatile("" : "+v"(tid));
    bf16_t* sW = (bf16_t*)lds; bf16_t* sVt = (bf16_t*)(lds + 34816);
    const int lane = tid & 63, wid = __builtin_amdgcn_readfirstlane(tid >> 6);
    const size_t m0 = (size_t)b * T + (size_t)n * 128;
    { const int i = tid >> 2, j0 = (tid & 3) * 32;
#pragma unroll
      for (int q = 0; q < 4; ++q) { const f32x4 w0 = *(const f32x4*)(Wl + i * 128 + j0 + 8 * q), w1 = *(const f32x4*)(Wl + i * 128 + j0 + 8 * q + 4);
          float x[8] = {w0.x, w0.y, w0.z, w0.w, w1.x, w1.y, w1.z, w1.w};
#pragma unroll
          for (int e = 0; e < 8; ++e) x[e] = (j0 + 8 * q + e <= i) ? x[e] : 0.f;
          *(u32x4*)(sW + i * 136 + j0 + 8 * q) = pack8(x); } }
    u32x2 uvv[8];
#pragma unroll
    for (int dt = 0; dt < 8; ++dt) uvv[dt] = *(const u32x2*)(P + (m0 + 16 * wid + (lane & 15)) * NINP + PC_U + h * 128 + 16 * dt + 4 * (lane >> 4));
    u32x4 xvv[4];
#pragma unroll
    for (int r = 0; r < 4; ++r) xvv[r] = *(const u32x4*)(P + (m0 + (tid >> 4) + 32 * r) * NINP + PC_VB + h * 128 + (tid & 15) * 8);
#pragma unroll
    for (int r = 0; r < 4; ++r) { const int j = (tid >> 4) + 32 * r, grp = tid & 15;
        const u32x4 xv = xvv[r];
        float x[8]; unpack8(xv, x); float ss = 0.f;
#pragma unroll
        for (int e = 0; e < 8; ++e) { x[e] = gelu_f(x[e]); ss += x[e] * x[e]; }
        ss = sum16(ss);
        const float rn = __builtin_amdgcn_rsqf(ss * (1.f / 128.f) + EPS);
        const f32x4 n0 = *(const f32x4*)(nl + grp * 8), n1 = *(const f32x4*)(nl + grp * 8 + 4);
        const float nn[8] = {n0.x, n0.y, n0.z, n0.w, n1.x, n1.y, n1.z, n1.w};
#pragma unroll
        for (int e = 0; e < 8; ++e) sVt[(grp * 8 + e) * 136 + j] = (bf16_t)f2bf(x[e] * rn * nn[e]); }
    LBAR();
    { const int fr = lane & 15, fq = lane >> 4;
      f32x4 acc[8];
#pragma unroll
      for (int dt = 0; dt < 8; ++dt) acc[dt] = (f32x4){0.f, 0.f, 0.f, 0.f};
      for (int ks = 0; ks <= (wid >> 1); ++ks) {
          const bf16x8 a = *(const bf16x8*)(sW + (16 * wid + fr) * 136 + 32 * ks + 8 * fq);
#pragma unroll
          for (int dt = 0; dt < 8; ++dt) { const bf16x8 bb = *(const bf16x8*)(sVt + (16 * dt + fr) * 136 + 32 * ks + 8 * fq); acc[dt] = MFMA16(bb, a, acc[dt]); } }
      const int i = 16 * wid + fr; const float bi = bl[i]; const size_t m = m0 + i;
#pragma unroll
      for (int dt = 0; dt < 8; ++dt) { const int d = 16 * dt + 4 * fq;
          const u32x2 uv = uvv[dt];
          const float u0 = gelu_f(lo_f(uv.x)), u1 = gelu_f(hi_f(uv.x)), u2 = gelu_f(lo_f(uv.y)), u3 = gelu_f(hi_f(uv.y));
          u32x2 o; o.x = pk2(u0 * (acc[dt][0] + bi), u1 * (acc[dt][1] + bi)); o.y = pk2(u2 * (acc[dt][2] + bi), u3 * (acc[dt][3] + bi));
          *(u32x2*)(MIX + m * D + 512 + h * 128 + d) = o; } }
    LBAR();
}

__device__ __forceinline__ void sample_item(unsigned char* lds, const float* PS  , const float* BA, const float* cw, float alog, float dtb, const float* stq, const float* S0, float* S1, float* qkvconv_out,
                                            float* sguv_out, const float* gdn, const float* sgn, float w00, float b0, bf16_t* MIX, int b, int h, int tid) {
    asm volatile("" : "+v"(tid));
    float* sq = (float*)lds; float* sk = sq + 128; float* sv = sq + 256; float* svn = sq + 384; float* so = sq + 512; float* ssc = sq + 640; float* redk = sq + 656; float* redq = redk + 2048;
    float* srow = redq + 2048;
    const int lane = tid & 63;
    const size_t m = (size_t)MP + b;
    const int dv4 = (tid & 31) * 4, kr = tid >> 5;
    f32x4 s0[8];
#pragma unroll
    for (int r = 0; r < 8; ++r) s0[r] = *(const f32x4*)(S0 + (kr + 16 * r) * 128 + dv4);
    for (int c4 = tid; c4 < NIN_G / 4; c4 += NTHR) { f32x4 a = *(const f32x4*)(PS + (size_t)b * NIN_G + 4 * c4);
#pragma unroll
        for (int ks = 1; ks < 4; ++ks) a += *(const f32x4*)(PS + ((size_t)ks * SB + b) * NIN_G + 4 * c4);
        *(f32x4*)(srow + 4 * c4) = a; }
    LBAR();
    if (tid < 64) {
        const int tensor = tid >> 4, grp = tid & 15; const bool act = tensor < 3;
        const int ch = (act ? tensor : 0) * 512 + h * 128 + grp * 8;
        float x[8];
        { const f32x4 x0 = *(const f32x4*)(srow + ch), x1 = *(const f32x4*)(srow + ch + 4); x[0] = x0.x; x[1] = x0.y; x[2] = x0.z; x[3] = x0.w; x[4] = x1.x; x[5] = x1.y; x[6] = x1.z; x[7] = x1.w; }
        float y[8];
        { const f32x4 w0 = *(const f32x4*)(cw + 3 * QKVD + ch), w1 = *(const f32x4*)(cw + 3 * QKVD + ch + 4);
          y[0] = w0.x * x[0]; y[1] = w0.y * x[1]; y[2] = w0.z * x[2]; y[3] = w0.w * x[3]; y[4] = w1.x * x[4]; y[5] = w1.y * x[5]; y[6] = w1.z * x[6]; y[7] = w1.w * x[7]; }
#pragma unroll
        for (int r = 0; r < 3; ++r) { const f32x4 s0 = *(const f32x4*)(stq + r * QKVD + ch), s1 = *(const f32x4*)(stq + r * QKVD + ch + 4);
            const f32x4 w0 = *(const f32x4*)(cw + r * QKVD + ch), w1 = *(const f32x4*)(cw + r * QKVD + ch + 4);
            y[0] += w0.x * s0.x; y[1] += w0.y * s0.y; y[2] += w0.z * s0.z; y[3] += w0.w * s0.w; y[4] += w1.x * s1.x; y[5] += w1.y * s1.y; y[6] += w1.z * s1.z; y[7] += w1.w * s1.w;
            if (act && r >= 1) { *(f32x4*)(qkvconv_out + (r - 1) * QKVD + ch) = s0; *(f32x4*)(qkvconv_out + (r - 1) * QKVD + ch + 4) = s1; } }
        if (act) { *(f32x4*)(qkvconv_out + 2 * QKVD + ch) = (f32x4){x[0], x[1], x[2], x[3]}; *(f32x4*)(qkvconv_out + 2 * QKVD + ch + 4) = (f32x4){x[4], x[5], x[6], x[7]}; }
        float ss = 0.f;
#pragma unroll
        for (int e = 0; e < 8; ++e) { y[e] = silu_f(y[e]); ss += y[e] * y[e]; }
        ss = sum16(ss);
        float rn = 1.f;
        if (tensor == 0) rn = __builtin_amdgcn_rsqf(ss + EPS) * 0.08838834764831845f; else if (tensor == 1) rn = __builtin_amdgcn_rsqf(ss + EPS);
        if (act) { float* dst = tensor == 0 ? sq : (tensor == 1 ? sk : sv);
#pragma unroll
            for (int e = 0; e < 8; ++e) dst[grp * 8 + e] = y[e] * rn; }
        { float pq = 0.f;
#pragma unroll
          for (int e = 0; e < 8; ++e) { const float kk = __shfl(y[e] * rn, (lane + 16) & 63); pq += y[e] * rn * kk; }
          pq = sum16(pq); if (tid == 0) ssc[2] = pq; }
        if (tid == 0) { const float braw = BA[m * 8 + h], araw = BA[m * 8 + 4 + h]; ssc[0] = 1.f / (1.f + __expf(-braw)); ssc[1] = __expf(-__expf(alog) * softplus_f(araw + dtb)); }
    }
    LBAR();
    const float beta = ssc[0], eg = ssc[1];
    f32x4 pk = {0.f, 0.f, 0.f, 0.f}, pq = {0.f, 0.f, 0.f, 0.f};
#pragma unroll
    for (int r = 0; r < 8; ++r) { const int kk = kr + 16 * r; pk += s0[r] * sk[kk]; pq += s0[r] * sq[kk]; }
    *(f32x4*)(redk + kr * 128 + dv4) = pk; *(f32x4*)(redq + kr * 128 + dv4) = pq;
    LBAR();
    if (tid < 128) { float kS = 0.f, qS = 0.f;
#pragma unroll
        for (int r = 0; r < 16; ++r) { kS += redk[r * 128 + tid]; qS += redq[r * 128 + tid]; }
        const float qk = ssc[2];
        const float vn = beta * (sv[tid] - eg * kS); svn[tid] = vn; so[tid] = eg * qS + qk * vn; }
    LBAR();
    { const f32x4 vn4 = *(const f32x4*)(svn + dv4);
#pragma unroll
      for (int r = 0; r < 8; ++r) { const int kk = kr + 16 * r; *(f32x4*)(S1 + kk * 128 + dv4) = s0[r] * eg + vn4 * sk[kk]; } }
    if (tid < 64) { const int d0 = 2 * lane; const float o0 = so[d0], o1 = so[d0 + 1];
        const float ss = wave_sum(o0 * o0 + o1 * o1); const float rn = __builtin_amdgcn_rsqf(ss * (1.f / 128.f) + EPS);
        const float z0 = srow[PC_Z + h * 128 + d0], z1 = srow[PC_Z + h * 128 + d0 + 1];
        *(unsigned*)(MIX + m * D + h * 128 + d0) = pk2(o0 * rn * gdn[d0] * silu_f(z0), o1 * rn * gdn[d0 + 1] * silu_f(z1)); }
    else if (tid < 128) { const int d0 = 2 * lane;
        const float g0 = gelu_f(srow[PC_VB + h * 128 + d0]), g1 = gelu_f(srow[PC_VB + h * 128 + d0 + 1]);
        const float ss = wave_sum(g0 * g0 + g1 * g1); const float rn = __builtin_amdgcn_rsqf(ss * (1.f / 128.f) + EPS);
        const float v0 = g0 * rn * sgn[d0], v1 = g1 * rn * sgn[d0 + 1];
        sguv_out[d0] = v0; sguv_out[d0 + 1] = v1;
        *(unsigned*)(MIX + m * D + 512 + h * 128 + d0) = pk2(gelu_f(srow[PC_U + h * 128 + d0]) * (w00 * v0 + b0), gelu_f(srow[PC_U + h * 128 + d0 + 1]) * (w00 * v1 + b0)); }
    LBAR();
}

__device__ __forceinline__ bf16x8 ld2(const bf16_t* p0, const bf16_t* p1) { const u32x2 a = *(const u32x2*)p0, b = *(const u32x2*)p1; u32x4 r; r.x = a.x; r.y = a.y; r.z = b.x; r.w = b.y; return __builtin_bit_cast(bf16x8, r); }
__device__ __forceinline__ bf16x8 packacc(const f32x4 a, const f32x4 b) { u32x4 r; r.x = pk2(a[0], a[1]); r.y = pk2(a[2], a[3]); r.z = pk2(b[0], b[1]); r.w = pk2(b[2], b[3]); return __builtin_bit_cast(bf16x8, r); }
constexpr int SC_NC = 2, SC_UT = 62464, SC_UTB = SC_NC * 2304, SC_EG = SC_UT + SC_UTB, SC_BUF = SC_EG + 128;
constexpr int SC_NLD = 256, SC_NQ = 16, SC_SLOT = 2 * SC_BUF, SC_SLOTV = SC_SLOT + SC_NC * 4096;
static_assert(SC_SLOTV + SC_NC * 2048 <= LDS_BYTES - 64 && SC_BUF % 16 == 0, "scan lds");
__device__ __forceinline__ bf16x8 ld2s(const bf16_t* p0) { const u32x2 a = *(const u32x2*)p0, b = *(const u32x2*)(p0 + 16); u32x4 r; r.x = a.x; r.y = a.y; r.z = b.x; r.w = b.y; return __builtin_bit_cast(bf16x8, r); }
struct ScanRegs { u32x4 r[SC_NQ]; u32x4 ru[2]; float eg; };
__device__ __forceinline__ void scan_issue(ScanRegs& R, const unsigned char* dr, int dv0, int lt) {
    const u32x4* g = (const u32x4*)dr;
#pragma unroll
    for (int q = 0; q < SC_NQ; ++q) { const int i = lt + SC_NLD * q; if (q < SC_NQ - 1 || lt < 3904 - SC_NLD * (SC_NQ - 1)) R.r[q] = g[i]; }
    const u32x4* gu = (const u32x4*)(dr + DR_UT + dv0 * 144);
    R.ru[0] = gu[lt]; if (lt < SC_UTB / 16 - 256) R.ru[1] = gu[lt + 256];
    if (lt == 0) R.eg = *(const float*)(dr + DR_EG);
}
__device__ __forceinline__ void scan_commit(const ScanRegs& R, unsigned char* buf, int lt) {
#pragma unroll
    for (int q = 0; q < SC_NQ; ++q) { const int i = lt + SC_NLD * q; if (q < SC_NQ - 1 || lt < 3904 - SC_NLD * (SC_NQ - 1)) ((u32x4*)buf)[i] = R.r[q]; }
    ((u32x4*)(buf + SC_UT))[lt] = R.ru[0]; if (lt < SC_UTB / 16 - 256) ((u32x4*)(buf + SC_UT))[lt + 256] = R.ru[1];
    if (lt == 0) *(float*)(buf + SC_EG) = R.eg;
}
constexpr int SCAN_ITEMS = 32 * (128 / (16 * SC_NC));
#define SCAN_BAR() do { asm volatile("s_waitcnt lgkmcnt(0)" ::: "memory"); __builtin_amdgcn_s_barrier(); asm volatile("" ::: "memory"); } while (0)
__device__ __forceinline__ void scan_item(unsigned char* lds, const unsigned char* drbase, float* OBUF, float* Sout, int item, int tid) {
    asm volatile("" : "+v"(tid));
    const int lane = tid & 63, wave = __builtin_amdgcn_readfirstlane(tid >> 6);
    constexpr int NSL = 128 / (16 * SC_NC);
    const int bh = item / NSL, cs = item % NSL, b = bh >> 2, h = bh & 3, dv0 = 16 * SC_NC * cs, fr = lane & 15, fq = lane >> 4;
    const unsigned char* dr0 = drbase + (size_t)((b * 32) * 4 + h) * DR_STRIDE;
    const bool ldr = wave >= 4; const int lt = tid - 256, w = wave;
    f32x4 S0[SC_NC], S1[SC_NC];
#pragma unroll
    for (int c = 0; c < SC_NC; ++c) { S0[c] = (f32x4){0.f, 0.f, 0.f, 0.f}; S1[c] = (f32x4){0.f, 0.f, 0.f, 0.f}; }
    if (ldr) {
        ScanRegs R0, R1, R2;
#pragma unroll
        for (int q = 0; q < SC_NQ; ++q) { R0.r[q] = (u32x4){0u, 0u, 0u, 0u}; R1.r[q] = (u32x4){0u, 0u, 0u, 0u}; R2.r[q] = (u32x4){0u, 0u, 0u, 0u}; }
        R0.ru[0] = R0.ru[1] = R1.ru[0] = R1.ru[1] = R2.ru[0] = R2.ru[1] = (u32x4){0u, 0u, 0u, 0u}; R0.eg = R1.eg = R2.eg = 0.f;
        scan_issue(R0, dr0, dv0, lt); scan_commit(R0, lds, lt);
        scan_issue(R1, dr0 + (size_t)1 * 4 * DR_STRIDE, dv0, lt); scan_issue(R2, dr0 + (size_t)2 * 4 * DR_STRIDE, dv0, lt); scan_issue(R0, dr0 + (size_t)3 * 4 * DR_STRIDE, dv0, lt);
        SCAN_BAR();
#define SCAN_LSTEP(S_, R_) do { const int s_ = (S_); if (s_ < 32) { if (s_ + 1 < 32) scan_commit(R_, lds + ((s_ + 1) & 1) * SC_BUF, lt); \
            if (s_ + 4 < 32) scan_issue(R_, dr0 + (size_t)(s_ + 4) * 4 * DR_STRIDE, dv0, lt); SCAN_BAR(); SCAN_BAR(); } } while (0)
#pragma unroll 1
        for (int s3 = 0; s3 < 33; s3 += 3) { SCAN_LSTEP(s3, R1); SCAN_LSTEP(s3 + 1, R2); SCAN_LSTEP(s3 + 2, R0); }
#undef SCAN_LSTEP
    } else {
    { unsigned vz; asm volatile("v_mov_b32 %0, 0" : "=v"(vz));
#pragma unroll
        for (int c = 0; c < SC_NC; ++c) *(u32x4*)(lds + SC_SLOT + (c * 4 + w) * 1024 + lane * 16) = (u32x4){vz, vz, vz, vz}; }
    SCAN_BAR();
#pragma unroll 1
    for (int ci = 0; ci < 32; ++ci) {
        const unsigned char* buf = lds + (ci & 1) * SC_BUF;
        const bf16_t* NW = (const bf16_t*)(buf + DR_NW); const bf16_t* QG = (const bf16_t*)(buf + DR_QG); const bf16_t* QK = (const bf16_t*)(buf + DR_QK);
        const bf16_t* KDT = (const bf16_t*)(buf + DR_KDT); const bf16_t* UT = (const bf16_t*)(buf + SC_UT);
        f32x4 o[SC_NC];
#pragma unroll
        for (int c = 0; c < SC_NC; ++c) o[c] = (f32x4){0.f, 0.f, 0.f, 0.f};
        {
            bf16x8 an[4], aq[4];
#pragma unroll
            for (int kp = 0; kp < 4; ++kp) { const int off = (16 * w + fr) * 136 + 32 * kp + 4 * fq; an[kp] = ld2s(NW + off); aq[kp] = ld2s(QG + off); }
#pragma unroll
            for (int c = 0; c < SC_NC; ++c) {
                bf16x8 sb[4];
#pragma unroll
                for (int kp = 0; kp < 4; ++kp) sb[kp] = *(const bf16x8*)(lds + SC_SLOT + (c * 4 + kp) * 1024 + lane * 16);
                f32x4 vn; { const u32x2 uv = *(const u32x2*)(UT + (16 * c + fr) * 72 + 16 * w + 4 * fq); vn = (f32x4){lo_f(uv.x), hi_f(uv.x), lo_f(uv.y), hi_f(uv.y)}; }
#pragma unroll
                for (int kp = 0; kp < 4; ++kp) vn = MFMA16(an[kp], sb[kp], vn);
                { u32x2 pv; pv.x = pk2(vn[0], vn[1]); pv.y = pk2(vn[2], vn[3]); *(u32x2*)(lds + SC_SLOTV + (c * 4 + w) * 512 + lane * 8) = pv; }
#pragma unroll
                for (int kp = 0; kp < 4; ++kp) o[c] = MFMA16(aq[kp], sb[kp], o[c]);
            }
        }
        SCAN_BAR();
        {
            const float eg = *(const float*)(buf + SC_EG);
            bf16x8 aqk[2], akd[2][2];
#pragma unroll
            for (int p = 0; p < 2; ++p) { aqk[p] = ld2s(QK + (16 * w + fr) * 72 + 32 * p + 4 * fq);
#pragma unroll
                for (int t = 0; t < 2; ++t) akd[t][p] = ld2s(KDT + (16 * (2 * w + t) + fr) * 72 + 32 * p + 4 * fq); }
#pragma unroll
            for (int c = 0; c < SC_NC; ++c) {
                bf16x8 vb[2];
#pragma unroll
                for (int p = 0; p < 2; ++p) { const u32x2 a = *(const u32x2*)(lds + SC_SLOTV + (c * 4 + 2 * p) * 512 + lane * 8), d = *(const u32x2*)(lds + SC_SLOTV + (c * 4 + 2 * p + 1) * 512 + lane * 8);
                    u32x4 r; r.x = a.x; r.y = a.y; r.z = d.x; r.w = d.y; vb[p] = __builtin_bit_cast(bf16x8, r); }
                S0[c] = S0[c] * eg; S1[c] = S1[c] * eg;
#pragma unroll
                for (int p = 0; p < 2; ++p) { S0[c] = MFMA16(akd[0][p], vb[p], S0[c]); S1[c] = MFMA16(akd[1][p], vb[p], S1[c]); o[c] = MFMA16(aqk[p], vb[p], o[c]); }
                *(u32x4*)(lds + SC_SLOT + (c * 4 + w) * 1024 + lane * 16) = __builtin_bit_cast(u32x4, packacc(S0[c], S1[c]));
                float* ob = OBUF + ((size_t)b * T + (size_t)ci * 64) * 512 + h * 128 + dv0 + 16 * c + fr;
#pragma unroll
                for (int jj = 0; jj < 4; ++jj) ob[(size_t)(16 * w + 4 * fq + jj) * 512] = o[c][jj];
            }
        }
        SCAN_BAR();
    }
    }
    if (!ldr) {
#pragma unroll
        for (int c = 0; c < SC_NC; ++c) { float* so = Sout + (size_t)(b * 4 + h) * 128 * 128 + dv0 + 16 * c + fr;
#pragma unroll
            for (int jj = 0; jj < 4; ++jj) { so[(32 * w + 4 * fq + jj) * 128] = S0[c][jj]; so[(32 * w + 16 + 4 * fq + jj) * 128] = S1[c][jj]; } }
    }
}

__device__ __forceinline__ void phase_gnorm(const float* OBUF, const bf16_t* P, const float* gdn, bf16_t* MIX, int gw, int ngw, int lane) {
    const int d = (8 * lane) & 127;
    const f32x4 g0 = *(const f32x4*)(gdn + d), g1 = *(const f32x4*)(gdn + d + 4);
    f32x4 an = {0.f, 0.f, 0.f, 0.f}, cn = {0.f, 0.f, 0.f, 0.f}; u32x4 zn = {0u, 0u, 0u, 0u};
    if (gw < MP) { an = *(const f32x4*)(OBUF + (size_t)gw * 512 + 8 * lane); cn = *(const f32x4*)(OBUF + (size_t)gw * 512 + 8 * lane + 4); zn = *(const u32x4*)(P + (size_t)gw * NINP + PC_Z + 8 * lane); }
    for (int m = gw; m < MP; m += ngw) {
        const f32x4 a = an, c = cn; const u32x4 zv = zn;
        { const int mn = m + ngw; if (mn < MP) { an = *(const f32x4*)(OBUF + (size_t)mn * 512 + 8 * lane); cn = *(const f32x4*)(OBUF + (size_t)mn * 512 + 8 * lane + 4); zn = *(const u32x4*)(P + (size_t)mn * NINP + PC_Z + 8 * lane); } }
        float ss = (a.x * a.x + a.y * a.y) + (a.z * a.z + a.w * a.w) + (c.x * c.x + c.y * c.y) + (c.z * c.z + c.w * c.w);
        ss = sum16(ss);
        const float rn = __builtin_amdgcn_rsqf(ss * (1.f / 128.f) + EPS);
        float z[8]; unpack8(zv, z);
        u32x4 o; o.x = pk2(a.x * rn * g0.x * silu_f(z[0]), a.y * rn * g0.y * silu_f(z[1])); o.y = pk2(a.z * rn * g0.z * silu_f(z[2]), a.w * rn * g0.w * silu_f(z[3]));
        o.z = pk2(c.x * rn * g1.x * silu_f(z[4]), c.y * rn * g1.y * silu_f(z[5])); o.w = pk2(c.z * rn * g1.z * silu_f(z[6]), c.w * rn * g1.w * silu_f(z[7]));
        *(u32x4*)(MIX + (size_t)m * D + 8 * lane) = o;
    }
}

__device__ __forceinline__ void ld8f(const float* p, float (&x)[8]) { const f32x4 a = *(const f32x4*)p, b = *(const f32x4*)(p + 4); x[0] = a.x; x[1] = a.y; x[2] = a.z; x[3] = a.w; x[4] = b.x; x[5] = b.y; x[6] = b.z; x[7] = b.w; }
__device__ __forceinline__ void st8f(float* p, const float (&x)[8]) { *(f32x4*)p = (f32x4){x[0], x[1], x[2], x[3]}; *(f32x4*)(p + 4) = (f32x4){x[4], x[5], x[6], x[7]}; }
__device__ __forceinline__ void phase_fixup(const float* RAW, const float* UPS, const float* cwf, const float* cbf, const float* stf, bf16_t* ACT, float* outp, float* outs, int gtid, int ngt) {
    constexpr int NSL = MP / 64;
    for (int idx = gtid; idx < (NSL * 2 + SB) * 352; idx += ngt) {
        const int rowi = idx / 352, c = (idx % 352) * 8;
        const int pn = c >> 7, cc = c & 127, cga = 256 * pn + cc;
        float r0[2][8], r1[2][8], r2[2][8];
        int m;
        if (rowi < NSL * 2) { const int s = rowi >> 1, q = rowi & 1; m = 64 * s + q; const bool first = (s & 31) == 0;
#pragma unroll
            for (int hf = 0; hf < 2; ++hf) { const int cg = cga + 128 * hf;
                const float* rs = RAW + (size_t)s * 4 * NUP + cg; const float* rp = RAW + (size_t)(s - 1) * 4 * NUP + cg;
#pragma unroll
                for (int e = 0; e < 8; ++e) { r0[hf][e] = 0.f; r1[hf][e] = 0.f; }
                if (q == 0) { ld8f(rs, r2[hf]); if (!first) { ld8f(rp + 2 * NUP, r0[hf]); ld8f(rp + 3 * NUP, r1[hf]); } }
                else { ld8f(rs + NUP, r2[hf]); ld8f(rs, r1[hf]); if (!first) ld8f(rp + 3 * NUP, r0[hf]); }
                if ((s & 31) == 31) { float t[8]; ld8f(rs + (size_t)(2 + q) * NUP, t); st8f(outp + ((size_t)(s >> 5) * 2 + q) * NUP + hf * DFF + c, t); } }
        } else { const int bs = rowi - NSL * 2; m = MP + bs;
#pragma unroll
            for (int hf = 0; hf < 2; ++hf) { const int cg = cga + 128 * hf, co = c + hf * DFF; const float* s = stf + (size_t)bs * 2 * NUP + co;
                ld8f(s, r0[hf]); ld8f(s + NUP, r1[hf]);
                f32x4 a0 = {0.f, 0.f, 0.f, 0.f}, a1 = {0.f, 0.f, 0.f, 0.f};
                { const float* qp = UPS + (size_t)bs * NUP + cg; a0 = *(const f32x4*)qp; a1 = *(const f32x4*)(qp + 4); }
                r2[hf][0] = a0.x; r2[hf][1] = a0.y; r2[hf][2] = a0.z; r2[hf][3] = a0.w; r2[hf][4] = a1.x; r2[hf][5] = a1.y; r2[hf][6] = a1.z; r2[hf][7] = a1.w;
                float* o = outs + (size_t)bs * 2 * NUP + co; st8f(o, r1[hf]); st8f(o + NUP, r2[hf]); } }
        float v[2][8];
#pragma unroll
        for (int hf = 0; hf < 2; ++hf) { const int co = c + hf * DFF; float w0[8], w1[8], w2[8], bb[8];
            ld8f(cwf + co, w0); ld8f(cwf + NUP + co, w1); ld8f(cwf + 2 * NUP + co, w2); ld8f(cbf + co, bb);
#pragma unroll
            for (int e = 0; e < 8; ++e) v[hf][e] = w0[e] * r0[hf][e] + w1[e] * r1[hf][e] + w2[e] * r2[hf][e] + bb[e]; }
        float o[8];
#pragma unroll
        for (int e = 0; e < 8; ++e) o[e] = silu_f(v[0][e]) * v[1][e];
        *(u32x4*)(ACT + (size_t)m * DFF + c) = pack8(o);
    }
}

#define LAS __attribute__((address_space(3)))
#define XB_TMO      128
#define XB_XCNT(j)  (256  + 64 * (j))
#define XB_XSUB(j)  (1280 + 64 * (j))
#define XB_XGEN(j)  (2304 + 64 * (j))
#define XB_TOP      3328
#define XB_TOPGEN   3392
#define XCD_BAR_WORDS 3456
#define XB_SPIN_CAP (1u << 18)

__device__ __forceinline__ unsigned xb_ld(unsigned* p)              { return __hip_atomic_load(p, __ATOMIC_RELAXED, __HIP_MEMORY_SCOPE_AGENT); }
__device__ __forceinline__ unsigned xb_add(unsigned* p, unsigned v) { return __hip_atomic_fetch_add(p, v, __ATOMIC_RELAXED, __HIP_MEMORY_SCOPE_AGENT); }
__device__ __forceinline__ unsigned xb_xcc_id() { return (unsigned)__builtin_amdgcn_s_getreg((3 << 11) | 20) & 0xFu; }
#define XB_SPIN(cond, bar) do { unsigned _sp = 0; while (cond) { __builtin_amdgcn_s_sleep(1); \
    if ((++_sp & 255u) == 0u) { if (xb_ld(&(bar)[XB_TMO])) break; if (_sp > XB_SPIN_CAP) { atomicAdd(&(bar)[XB_TMO], 1u); break; } } } } while (0)

struct XcdBarrier {
    unsigned* bar; unsigned x;
    volatile LAS unsigned* st;
};

__device__ __forceinline__ XcdBarrier xcd_barrier_post(unsigned* bar, volatile LAS unsigned* st) {
    XcdBarrier b; b.bar = bar; b.x = xb_xcc_id(); b.st = st;
    if (threadIdx.x == 0) (void)xb_add(&bar[XB_XCNT(b.x)], 1u);
    return b;
}
__device__ __forceinline__ void xcd_barrier_complete(unsigned* bar, unsigned x, unsigned& nloc, unsigned& nx) {
    const unsigned G = gridDim.x * gridDim.y * gridDim.z;
    unsigned sum, cnt, mine, sp = 0u;
    for (;;) {
        sum = 0u; cnt = 0u; mine = 0u;
#pragma unroll
        for (unsigned j = 0; j < 16; ++j) { const unsigned c = xb_ld(&bar[XB_XCNT(j)]); sum += c; cnt += (c > 0u) ? 1u : 0u; mine = (j == x) ? c : mine; }
        if (sum == G) break;
        __builtin_amdgcn_s_sleep(1);
        if ((++sp & 255u) == 0u) { if (xb_ld(&bar[XB_TMO])) break; if (sp > XB_SPIN_CAP) { atomicAdd(&bar[XB_TMO], 1u); break; } }
    }
    nloc = mine > 0u ? mine : 1u; nx = cnt > 0u ? cnt : 1u;
}

__device__ __forceinline__ void xcd_barrier(const XcdBarrier& b) {
    asm volatile("s_waitcnt vmcnt(0)" ::: "memory");
    __syncthreads();
    if (threadIdx.x == 0) {
        unsigned* bar = b.bar;
        __builtin_amdgcn_s_waitcnt(0);
        unsigned nloc = b.st[0], nx = b.st[1];
        if (nloc == 0u) { xcd_barrier_complete(bar, b.x, nloc, nx); b.st[0] = nloc; b.st[1] = nx; }
        const unsigned old = xb_add(&bar[XB_XSUB(b.x)], 1u);
        const unsigned gen = old / nloc;
        if (old + 1u == (gen + 1u) * nloc) {
            __builtin_amdgcn_fence(__ATOMIC_RELEASE, "agent");
            asm volatile("s_waitcnt vmcnt(0)" ::: "memory");
            const unsigned og = xb_add(&bar[XB_TOP], 1u);
            const unsigned tg = og / nx;
            if (og + 1u == (tg + 1u) * nx) xb_add(&bar[XB_TOPGEN], 1u);
            else XB_SPIN(xb_ld(&bar[XB_TOPGEN]) == tg, bar);
            __builtin_amdgcn_fence(__ATOMIC_ACQUIRE, "agent");
            xb_add(&bar[XB_XGEN(b.x)], 1u);
            asm volatile("s_waitcnt vmcnt(0)" ::: "memory");
        } else {
            XB_SPIN(xb_ld(&bar[XB_XGEN(b.x)]) == gen, bar);
            __builtin_amdgcn_fence(__ATOMIC_ACQUIRE, "agent");
            asm volatile("s_waitcnt vmcnt(0)" ::: "memory");
        }
    }
    __syncthreads();
}

struct Args { const float* in[25]; float* out; unsigned char* ws; int ph_lo, ph_hi; };
constexpr int N_PHASES = 2 + 10 * DEPTH + 1;

#define MOD ((float*)(wsl + WS_MOD))
#define XR ((float*)(wsl + WS_XR))
#define AB ((bf16_t*)(wsl + WS_AB))
#define PB ((bf16_t*)(wsl + WS_BIG))
#define OBUF ((float*)(wsl + WS_OBUF))
#define ACT ((bf16_t*)(wsl + WS_ACT))
#define PSb ((float*)(wsl + WS_PS))
#define UPSb ((float*)(wsl + WS_UPS))
#define RPb ((float*)(wsl + WS_RP))
#define BAb ((float*)(wsl + WS_BA))
#define wl ((const unsigned char*)(wsl + WS_W + (size_t)l * WL_STRIDE))
#define modl ((const float*)(MOD + l * NMOD))
__global__ void __launch_bounds__(NTHR, 2) fwd_kernel(Args args) {
    extern __shared__ __attribute__((aligned(16))) unsigned char lds[];
    cg::grid_group grid = cg::this_grid();
    const int G = gridDim.x, bx = blockIdx.x, ngw = G * NWAVES;
#define TIDS() int tid = threadIdx.x; asm volatile("" : "+v"(tid)); const int lane = tid & 63, wave = __builtin_amdgcn_readfirstlane(tid >> 6), gw = bx * NWAVES + wave; (void)lane; (void)wave; (void)gw
    unsigned char* ws = args.ws;
    const int lo = args.ph_lo, hi = args.ph_hi;
#ifndef PMASK
#define PMASK 0xFFFF
#endif
#define RUN(k) (lo <= (k) && (k) < hi)
#define EN(b) ((PMASK >> (b)) & 1)
#ifndef REPMASK
#define REPMASK 0
#endif
#ifndef NREP
#define NREP 2
#endif
#define GSYNC() xcd_barrier(xbar)
#define SEAM(k) do { if (RUN(k) && RUN((k) + 1)) GSYNC(); } while (0)
    PG8_LAS unsigned char* glds = (PG8_LAS unsigned char*)lds;
    volatile LAS unsigned* MISC = (volatile LAS unsigned*)(glds + (LDS_BYTES - 64));
    if (threadIdx.x < 16) MISC[threadIdx.x] = 0u;
    __syncthreads();
    XcdBarrier xbar; xbar.bar = (unsigned*)ws; xbar.x = 0; xbar.st = nullptr;
    if (hi - lo > 1) xbar = xcd_barrier_post((unsigned*)ws, MISC + 8);
    if (hi < lo) grid.sync();

    if (EN(10) && RUN(0)) for (int rep_ = 0; rep_ < 1 + NREP * ((REPMASK >> 10) & 1); ++rep_) { if (rep_) GSYNC(); unsigned char* wsl = args.ws; asm volatile("" : "+s"(wsl)); TIDS(); phase_convert(lds, wsl, args.in[10], args.in[18], args.in[20], args.in[23], args.in[7], args.in[5], args.in[6], gw, ngw, wave, lane); }
    SEAM(0);
    if (EN(11) && RUN(1)) for (int rep_ = 0; rep_ < 1 + NREP * ((REPMASK >> 11) & 1); ++rep_) { if (rep_) GSYNC(); unsigned char* wsl = args.ws; asm volatile("" : "+s"(wsl)); pg8::Gemm g{(const bf16_t*)(wsl + WS_CACT), (const bf16_t*)(wsl + WS_WMODT), 256, MODLD, D, D}; pg8::StaticOrder S; S.init(256, MODLD, G, bx);
        EpiMod E{MOD, args.in[8]}; pg8::gemm_phase<EpiMod, pg8::StaticOrder>(glds, g, S, E, nullptr); }
    SEAM(1);
#pragma unroll 1
    for (int l = 0; l < DEPTH; ++l) {
        const int pb = 2 + 10 * l;
        if (EN(0) && RUN(pb + 0)) for (int rep_ = 0; rep_ < 1 + NREP * ((REPMASK >> 0) & 1); ++rep_) { if (rep_) GSYNC(); unsigned char* wsl = args.ws; asm volatile("" : "+s"(wsl)); TIDS();
            fill_tba((float*)lds, args.in[10] + (size_t)l * D * NIN, tid);
            if (l == 0) phase_ln(args.in[0], args.in[1], args.in[9], modl + 0 * D, modl + 1 * D, AB, XR, nullptr, 0, nullptr, nullptr, (const f32x4*)lds, BAb, gw, ngw, lane);
            else phase_ln(XR, XR + (size_t)MP * D, args.in[9] + l * D, modl + 0 * D, modl + 1 * D, AB, nullptr, RPb, 11, modl - NMOD + 5 * D, XR, (const f32x4*)lds, BAb, gw, ngw, lane);
            __syncthreads();
        }
        SEAM(pb + 0);
        if (EN(1) && RUN(pb + 1)) for (int rep_ = 0; rep_ < 1 + NREP * ((REPMASK >> 1) & 1); ++rep_) { if (rep_) GSYNC(); unsigned char* wsl = args.ws; asm volatile("" : "+s"(wsl)); pg8::Gemm g{AB, (const bf16_t*)(wl + WL_IN), MP, NIN_G, D, D}; pg8::StaticOrder S; S.init(MP, NIN_G, G, bx);
            EpiBf E{PB, NINP}; pg8::gemm_phase<EpiBf, pg8::StaticOrder>(glds, g, S, E, nullptr);
            { pg8::Gemm g2{AB, (const bf16_t*)(wl + WL_IN), MPAD, NIN_G, 256, D}; pg8::SplitOrder S2; S2.init(NIN_G, 4, 256, MP / 256, G, bx);
              EpiPart E2{PSb, NIN_G, 256}; pg8::gemm_phase<EpiPart, pg8::SplitOrder>(glds, g2, S2, E2, nullptr); } }
        SEAM(pb + 1);
        if (EN(2) && RUN(pb + 2)) for (int rep_ = 0; rep_ < 1 + NREP * ((REPMASK >> 2) & 1); ++rep_) { if (rep_) GSYNC(); unsigned char* wsl = args.ws; asm volatile("" : "+s"(wsl)); TIDS();
            const float* cw = args.in[11] + (size_t)l * 4 * QKVD;
            {
                PrepIn pa, pn;
                if (bx < 1024) prep_fetch(pa, PB, BAb, bx >> 7, (bx >> 2) & 31, bx & 3, tid);
#pragma unroll 1
                for (int it = bx; it < 1024; it += G) { const int h = it & 3, ci = (it >> 2) & 31, b = it >> 7; const int nit = it + G; const bool hn = nit < 1024;
                    prep_item(lds, PB, BAb, cw, args.in[12][l * 4 + h], args.in[13][l * 4 + h], wsl + WS_ACT + (size_t)it * DR_STRIDE,
                              ci == 31 ? args.out + O_QP + ((size_t)l * NB + b) * 3 * QKVD : nullptr, b, ci, h, tid, pa, pn, hn, nit >> 7, (nit >> 2) & 31, nit & 3);
                    pa = pn; }
            }
            for (int it = 1024 + bx; it < 1280; it += G) { const int j = it - 1024, h = j & 3, n = (j >> 2) & 15, b = j >> 6;
                sgu_item(lds, PB, args.in[16] + ((size_t)l * 4 + h) * 128 * 128, args.in[17] + (l * 4 + h) * 128, args.in[15] + (l * 4 + h) * 128, AB, b, n, h, tid); }
        }
        SEAM(pb + 2);
        if (EN(3) && RUN(pb + 3)) for (int rep_ = 0; rep_ < 1 + NREP * ((REPMASK >> 3) & 1); ++rep_) { if (rep_) GSYNC(); unsigned char* wsl = args.ws; asm volatile("" : "+s"(wsl)); TIDS(); const int nscan = SCAN_ITEMS < G ? SCAN_ITEMS : G, nrest = G - nscan;
            if (bx < nscan) for (int v = bx; v < SCAN_ITEMS; v += nscan) { const int nsl = SCAN_ITEMS / 32, xcd = v & 7, j = v >> 3, it = (xcd * 4 + j / nsl) * nsl + (j % nsl);
                scan_item(lds, wsl + WS_ACT, OBUF, args.out + O_DP + (size_t)l * NB * 4 * 128 * 128, it, tid); }
            if (nrest == 0 || bx >= nscan) { const int r0 = nrest ? bx - nscan : bx, rs = nrest ? nrest : G;
            const float* cw = args.in[11] + (size_t)l * 4 * QKVD;
            for (int it = 1280 + r0; it < 2048; it += rs) {
                if (it < 1536) { const int j = it - 1024, h = j & 3, n = (j >> 2) & 15, b = j >> 6;
                    sgu_item(lds, PB, args.in[16] + ((size_t)l * 4 + h) * 128 * 128, args.in[17] + (l * 4 + h) * 128, args.in[15] + (l * 4 + h) * 128, AB, b, n, h, tid); }
                else { const int j = it - 1536, h = j & 3, b = j >> 2;
                    sample_item(lds, PSb, BAb, cw, args.in[12][l * 4 + h], args.in[13][l * 4 + h], args.in[3] + ((size_t)l * SB + b) * 3 * QKVD,
                                args.in[2] + (((size_t)l * SB + b) * 4 + h) * 128 * 128, args.out + O_DS + (((size_t)l * SB + b) * 4 + h) * 128 * 128,
                                args.out + O_QS + ((size_t)l * SB + b) * 3 * QKVD, args.out + O_SV + (((size_t)l * SB + b) * 4 + h) * 128,
                                args.in[14] + l * 128, args.in[15] + (l * 4 + h) * 128, args.in[16][((size_t)l * 4 + h) * 128 * 128], args.in[17][(l * 4 + h) * 128], AB, b, h, tid); }
            }
            }
        }
        SEAM(pb + 3);
        if (EN(4) && RUN(pb + 4)) for (int rep_ = 0; rep_ < 1 + NREP * ((REPMASK >> 4) & 1); ++rep_) { if (rep_) GSYNC(); unsigned char* wsl = args.ws; asm volatile("" : "+s"(wsl)); TIDS(); phase_gnorm(OBUF, PB, args.in[14] + l * 128, AB, gw, ngw, lane); }
        SEAM(pb + 4);
        if (EN(5) && RUN(pb + 5)) for (int rep_ = 0; rep_ < 1 + NREP * ((REPMASK >> 5) & 1); ++rep_) { if (rep_) GSYNC(); unsigned char* wsl = args.ws; asm volatile("" : "+s"(wsl)); pg8::Gemm g{AB, (const bf16_t*)(wl + WL_OUT), MP, D, D, D}; pg8::StaticOrder S; S.init(MP, D, G, bx);
            EpiRes E{XR, rep_ ? (const float*)(wsl + 16384) : modl + 2 * D, rep_ ? 0 : MODLD}; pg8::gemm_phase<EpiRes, pg8::StaticOrder>(glds, g, S, E, nullptr);
            { pg8::Gemm g2{AB, (const bf16_t*)(wl + WL_OUT), MPAD, D, 256, D}; pg8::SplitOrder S2; S2.init(D, 4, 256, MP / 256, G, bx);
              EpiPart E2{RPb, D, 256}; pg8::gemm_phase<EpiPart, pg8::SplitOrder>(glds, g2, S2, E2, nullptr); } }
        SEAM(pb + 5);
        if (EN(6) && RUN(pb + 6)) for (int rep_ = 0; rep_ < 1 + NREP * ((REPMASK >> 6) & 1); ++rep_) { if (rep_) GSYNC(); unsigned char* wsl = args.ws; asm volatile("" : "+s"(wsl)); TIDS(); phase_ln(XR, XR + (size_t)MP * D, args.in[19] + l * D, modl + 3 * D, modl + 4 * D, AB, nullptr, RPb, 4, modl + 2 * D, XR, nullptr, nullptr, gw, ngw, lane); }
        SEAM(pb + 6);
        if (EN(7) && RUN(pb + 7)) for (int rep_ = 0; rep_ < 1 + NREP * ((REPMASK >> 7) & 1); ++rep_) { if (rep_) GSYNC(); unsigned char* wsl = args.ws; asm volatile("" : "+s"(wsl)); pg8::Gemm g{AB, (const bf16_t*)(wl + WL_UP), MPAD, NUP, D, D}; pg8::StaticOrder S; S.init(MPAD, NUP, G, bx);
            EpiUpCG E{ACT, (float*)(wsl + WS_RAW), args.in[21] + (size_t)l * 3 * NUP, args.in[22] + (size_t)l * NUP}; pg8::gemm_phase<EpiUpCG, pg8::StaticOrder>(glds, g, S, E, nullptr);
            }
        SEAM(pb + 7);
        if (EN(8) && RUN(pb + 8)) for (int rep_ = 0; rep_ < 1 + NREP * ((REPMASK >> 8) & 1); ++rep_) { if (rep_) GSYNC(); unsigned char* wsl = args.ws; asm volatile("" : "+s"(wsl)); TIDS(); phase_fixup((const float*)(wsl + WS_RAW), (const float*)(wsl + WS_UPS), args.in[21] + (size_t)l * 3 * NUP, args.in[22] + (size_t)l * NUP, args.in[4] + (size_t)l * SB * 2 * NUP, ACT,
                                        args.out + O_FP + (size_t)l * NB * 2 * NUP, args.out + O_FS + (size_t)l * SB * 2 * NUP, bx * NTHR + tid, G * NTHR); }
        SEAM(pb + 8);
        if (EN(9) && RUN(pb + 9)) for (int rep_ = 0; rep_ < 1 + NREP * ((REPMASK >> 9) & 1); ++rep_) { if (rep_) GSYNC(); unsigned char* wsl = args.ws; asm volatile("" : "+s"(wsl)); pg8::Gemm g{ACT, (const bf16_t*)(wl + WL_DOWN), MP, D, DFF, DFF}; pg8::StaticOrder S; S.init(MP, D, G, bx);
            EpiRes E{XR, rep_ ? (const float*)(wsl + 16384) : modl + 5 * D, rep_ ? 0 : MODLD}; pg8::gemm_phase<EpiRes, pg8::StaticOrder>(glds, g, S, E, nullptr);
            { pg8::Gemm g2{ACT, (const bf16_t*)(wl + WL_DOWN), MPAD, D, 256, DFF}; pg8::SplitOrder S2; S2.init(D, 11, 256, MP / 256, G, bx);
              EpiPart E2{RPb, D, 256}; pg8::gemm_phase<EpiPart, pg8::SplitOrder>(glds, g2, S2, E2, nullptr); } }
        SEAM(pb + 9);
    }
    if (EN(12) && RUN(N_PHASES - 1)) for (int rep_ = 0; rep_ < 1 + NREP * ((REPMASK >> 12) & 1); ++rep_) { if (rep_) GSYNC(); unsigned char* wsl = args.ws; asm volatile("" : "+s"(wsl)); TIDS(); phase_final(XR, args.in[24], args.out + O_Y, RPb, 11, MOD + 3 * NMOD + 5 * D, gw, ngw, lane); }
#ifdef EXTRA_SYNCS
    if (hi - lo > 1) for (int i = 0; i < EXTRA_SYNCS; ++i) GSYNC();
#endif
#undef RUN
#undef SEAM
}

#ifndef MK_MULTI
#define MK_MULTI 0
#endif
extern "C" void kernel_launch(void* const* d_in, const int* in_sizes, int n_in, void* d_out, int out_size, void* d_ws, size_t ws_size, hipStream_t stream) {
    static int grid = 0;
    if (grid == 0) {
        if (n_in != 25 || (size_t)out_size != O_END || ws_size < WS_END) { fprintf(stderr, "kernel_launch: unexpected shapes (n_in %d out %d ws %zu need %zu)\n", n_in, out_size, ws_size, (size_t)WS_END); grid = -1; return; }
        int dev = 0, cus = 0, per_cu = 0;
        hipGetDevice(&dev); hipDeviceGetAttribute(&cus, hipDeviceAttributeMultiprocessorCount, dev);
        if (hipFuncSetAttribute((const void*)fwd_kernel, hipFuncAttributeMaxDynamicSharedMemorySize, LDS_BYTES) != hipSuccess) { fprintf(stderr, "kernel_launch: hipFuncSetAttribute failed\n"); grid = -1; return; }
        if (hipOccupancyMaxActiveBlocksPerMultiprocessor(&per_cu, (const void*)fwd_kernel, NTHR, LDS_BYTES) != hipSuccess || per_cu < 1) { fprintf(stderr, "kernel_launch: occupancy query says %d\n", per_cu); per_cu = 1; }
        (void)hipGetLastError();
        grid = cus;
    }
    if (grid < 0) return;
    Args a{};
    for (int i = 0; i < 25; ++i) a.in[i] = (const float*)d_in[i];
    a.out = (float*)d_out; a.ws = (unsigned char*)d_ws;
    if (hipMemsetAsync(d_ws, 0, 32768, stream) != hipSuccess) { fprintf(stderr, "kernel_launch: memset failed\n"); return; }
#if MK_MULTI
    for (int p = 0; p < N_PHASES; ++p) { a.ph_lo = p; a.ph_hi = p + 1; hipLaunchKernelGGL(fwd_kernel, dim3(grid), dim3(NTHR), LDS_BYTES, stream, a); }
#else
    a.ph_lo = 0; a.ph_hi = N_PHASES;
    void* kargs[] = {&a};
    hipError_t e = hipLaunchCooperativeKernel((const void*)fwd_kernel, dim3(grid), dim3(NTHR), kargs, LDS_BYTES, stream);
    if (e != hipSuccess) fprintf(stderr, "kernel_launch: cooperative launch failed: %s\n", hipGetErrorString(e));
#endif
}
```
